# Optimizing an MI355X kernel written in HIP

```python
import jax, jax.numpy as jnp
from jax import lax
import numpy as np

D_MODEL = 1024
BATCH = 8
SEQ = 4096
DEPTH = 4

CHUNK = 64
Q_BLOCK = 2 * CHUNK
HEAD_DIM = 64
SB_WIDTH = D_MODEL // 2
SB_HEADS = SB_WIDTH // HEAD_DIM
CONV_WIDTH = D_MODEL // 4
CONV_K = 3
POOL_WINDOWS = (2, 4, 8, 16)
POOL_GROUPS = len(POOL_WINDOWS)
POOL_WIDTH = D_MODEL // 4
POOL_GDIM = POOL_WIDTH // POOL_GROUPS
MIX_WIDTH = SB_WIDTH + CONV_WIDTH + POOL_WIDTH
IN_WIDTH = 3 * SB_WIDTH + 3 * CONV_WIDTH + POOL_WIDTH
D_FF = 2816
N_MOD = 9
EPS = 1e-6

kernel_name = "hybrid_sb_conv_pool_macaron_adaln"


def rms_norm(x, gain):
    x32 = x.astype(jnp.float32)
    y = x32 * lax.rsqrt(jnp.mean(x32 * x32, axis=-1, keepdims=True) + EPS)
    return y.astype(x.dtype) * gain.astype(x.dtype)


def modulate(h, shift, scale):
    return h * (1 + scale[:, None, :]) + shift[:, None, :]


def swiglu(h, w_gate, w_up, w_down):
    return (jax.nn.silu(h @ w_gate) * (h @ w_up)) @ w_down


def stick_breaking_attention(q, k, v):
    seq = q.shape[2]
    scale = q.shape[-1] ** -0.5
    outs = []
    for i in range(seq // Q_BLOCK):
        q0 = i * Q_BLOCK
        kv_len = q0 + Q_BLOCK
        qb = q[:, :, q0:kv_len]
        kb = k[:, :, :kv_len]
        vb = v[:, :, :kv_len]
        z = jnp.einsum('bhqd,bhkd->bhqk', qb, kb).astype(jnp.float32) * scale
        t_pos = q0 + jnp.arange(Q_BLOCK)[:, None]
        s_pos = jnp.arange(kv_len)[None, :]
        past = s_pos < t_pos
        log_keep = jnp.where(past, -jax.nn.softplus(z), 0.0)
        suffix = lax.cumsum(log_keep, axis=3, reverse=True) - log_keep
        log_a = jax.nn.log_sigmoid(z) + suffix
        a = jnp.where(past, jnp.exp(log_a), 0.0)
        outs.append(jnp.einsum('bhqk,bhkd->bhqd', a.astype(vb.dtype), vb))
    return jnp.concatenate(outs, axis=2)


def short_conv_mixer(u, gate_b, gate_c, conv_w):
    cu = gate_c * u
    y = lax.conv_general_dilated(
        cu, conv_w[:, None, :].astype(cu.dtype), window_strides=(1,),
        padding=[(CONV_K - 1, 0)], dimension_numbers=('NWC', 'WIO', 'NWC'),
        feature_group_count=cu.shape[-1])
    return gate_b * y


def multiscale_pool_mixer(p, pool_w, pool_scale):
    bsz, seq, _ = p.shape
    pg = p.reshape(bsz, seq, POOL_GROUPS, POOL_GDIM)
    cs = jnp.cumsum(pg.astype(jnp.float32), axis=1)
    t1 = jnp.arange(1, seq + 1, dtype=jnp.float32)
    pooled = []
    for g, w in enumerate(POOL_WINDOWS):
        c_g = cs[:, :, g]
        lagged = jnp.pad(c_g, ((0, 0), (w, 0), (0, 0)))[:, :seq]
        count = jnp.minimum(t1, float(w))[None, :, None]
        pooled.append((c_g - lagged) / count)
    pooled = jnp.stack(pooled, axis=2).astype(p.dtype) - pg
    y = jnp.einsum('bsgc,gcd->bsgd', pooled, pool_w).reshape(bsz, seq, POOL_WIDTH)
    return y * pool_scale


def setup_inputs(seed: int = 0) -> dict:
    key = jax.random.key(seed)
    ks = jax.random.split(key, 24)
    f32 = jnp.float32
    nrm = lambda k, shape, s: jax.random.normal(k, shape, f32) * s
    gain = lambda k, shape: 1.0 + 0.02 * jax.random.normal(k, shape, f32)
    L = DEPTH
    return {
        "x": jax.random.normal(ks[0], (BATCH, SEQ, D_MODEL), f32),
        "c": jax.random.normal(ks[1], (BATCH, D_MODEL), f32),
        "w_ada": nrm(ks[2], (L, D_MODEL, N_MOD * D_MODEL), 0.1 * D_MODEL ** -0.5),
        "b_ada": nrm(ks[3], (L, N_MOD * D_MODEL), 0.01),
        "ffn1_norm": gain(ks[4], (L, D_MODEL)),
        "ffn1_gate": nrm(ks[5], (L, D_MODEL, D_FF), D_MODEL ** -0.5),
        "ffn1_up": nrm(ks[6], (L, D_MODEL, D_FF), D_MODEL ** -0.5),
        "ffn1_down": nrm(ks[7], (L, D_FF, D_MODEL), D_FF ** -0.5),
        "mix_norm": gain(ks[8], (L, D_MODEL)),
        "w_in": nrm(ks[9], (L, D_MODEL, IN_WIDTH), D_MODEL ** -0.5),
        "q_norm": gain(ks[10], (L, HEAD_DIM)),
        "k_norm": gain(ks[11], (L, HEAD_DIM)),
        "conv_w": nrm(ks[12], (L, CONV_K, CONV_WIDTH), CONV_K ** -0.5),
        "pool_w": nrm(ks[13], (L, POOL_GROUPS, POOL_GDIM, POOL_GDIM), POOL_GDIM ** -0.5),
        "pool_scale": gain(ks[14], (L, POOL_WIDTH)),
        "w_out": nrm(ks[15], (L, MIX_WIDTH, D_MODEL), MIX_WIDTH ** -0.5),
        "ffn2_norm": gain(ks[16], (L, D_MODEL)),
        "ffn2_gate": nrm(ks[17], (L, D_MODEL, D_FF), D_MODEL ** -0.5),
        "ffn2_up": nrm(ks[18], (L, D_MODEL, D_FF), D_MODEL ** -0.5),
        "ffn2_down": nrm(ks[19], (L, D_FF, D_MODEL), D_FF ** -0.5),
    }


def reference(x, c, w_ada, b_ada, ffn1_norm, ffn1_gate, ffn1_up, ffn1_down,
              mix_norm, w_in, q_norm, k_norm, conv_w, pool_w, pool_scale, w_out,
              ffn2_norm, ffn2_gate, ffn2_up, ffn2_down):
    bsz, seq, _ = x.shape
    splits = [SB_WIDTH, 2 * SB_WIDTH, 3 * SB_WIDTH,
              3 * SB_WIDTH + CONV_WIDTH, 3 * SB_WIDTH + 2 * CONV_WIDTH,
              3 * SB_WIDTH + 3 * CONV_WIDTH]
    cond = jax.nn.silu(c)

    def to_heads(t):
        return t.reshape(bsz, seq, SB_HEADS, HEAD_DIM).transpose(0, 2, 1, 3)

    for l in range(DEPTH):
        mod = cond @ w_ada[l] + b_ada[l]
        sh1, sc1, g1, sh2, sc2, g2, sh3, sc3, g3 = jnp.split(mod, N_MOD, axis=-1)

        h = modulate(rms_norm(x, ffn1_norm[l]), sh1, sc1)
        x = x + 0.5 * (1 + g1)[:, None, :] * swiglu(h, ffn1_gate[l], ffn1_up[l], ffn1_down[l])

        h = modulate(rms_norm(x, mix_norm[l]), sh2, sc2)
        proj = h @ w_in[l]
        q, k, v, cb, cc, cu, p = jnp.split(proj, splits, axis=-1)
        q = rms_norm(to_heads(q), q_norm[l])
        k = rms_norm(to_heads(k), k_norm[l])
        y_sb = stick_breaking_attention(q, k, to_heads(v))
        y_sb = y_sb.transpose(0, 2, 1, 3).reshape(bsz, seq, SB_WIDTH)
        y_conv = short_conv_mixer(cu, cb, cc, conv_w[l])
        y_pool = multiscale_pool_mixer(p, pool_w[l], pool_scale[l])
        mixed = jnp.concatenate([y_sb, y_conv, y_pool], axis=-1) @ w_out[l]
        x = x + (1 + g2)[:, None, :] * mixed

        h = modulate(rms_norm(x, ffn2_norm[l]), sh3, sc3)
        x = x + 0.5 * (1 + g3)[:, None, :] * swiglu(h, ffn2_gate[l], ffn2_up[l], ffn2_down[l])
    return x
```

```cpp
#include <hip/hip_runtime.h>
#include <hip/hip_cooperative_groups.h>
#include <cstdio>
#include <cstdint>
namespace cg = cooperative_groups;

#ifndef REP_GU
#define REP_GU 1
#endif
#ifndef REP_MIX
#define REP_MIX 1
#endif
#ifndef REP_PRO
#define REP_PRO 1
#endif
#ifndef REP_IN
#define REP_IN 1
#endif
#ifndef REP_RES
#define REP_RES 1
#endif
#ifndef MK_MULTI_LAUNCH
#define MK_MULTI_LAUNCH 0
#endif

#define LAS __attribute__((address_space(3)))
typedef unsigned short bf16_t;
typedef short bf16x8 __attribute__((ext_vector_type(8)));
typedef float f32x4 __attribute__((ext_vector_type(4)));
typedef float f32x16 __attribute__((ext_vector_type(16)));
typedef unsigned u32x4 __attribute__((ext_vector_type(4)));
typedef unsigned u32x2 __attribute__((ext_vector_type(2)));
typedef float f32x2_t __attribute__((ext_vector_type(2)));
typedef __bf16 bf16x2_t __attribute__((ext_vector_type(2)));

constexpr int NL = 4, NBATCH = 8, SEQ = 4096, DM = 1024, FF = 2816, MTOK = NBATCH * SEQ;
constexpr int PW = 2048;
constexpr int NMOD = 9 * DM;
constexpr float EPS = 1e-6f;
constexpr float LOG2E = 1.4426950408889634f;
constexpr float QSCALE = 0.125f * LOG2E;

constexpr size_t MiB = 1u << 20;
constexpr size_t WS_MOD = 0;
constexpr size_t WS_CTL = 1536 * 1024;
constexpr size_t WS_WGU = 2 * MiB;
constexpr size_t WS_WD = 90 * MiB;
constexpr size_t WS_WIN = 134 * MiB;
constexpr size_t WS_WV = 150 * MiB;
constexpr size_t WS_WOUT = 154 * MiB;
constexpr size_t WS_H = 162 * MiB;
constexpr size_t WS_ACT = 226 * MiB;
constexpr size_t WS_PROJ = 226 * MiB;
constexpr size_t WS_VT = 354 * MiB;
constexpr size_t WS_STATS = 402 * MiB;
constexpr size_t WS_SW = 403 * MiB;
constexpr size_t WS_MIX = 406 * MiB;
constexpr size_t WS_XB = 470 * MiB;
constexpr size_t WS_END = 534 * MiB;
constexpr int SW_ROWS = 5632 + 2048 + 512 + 5632, SW_GU1 = 0, SW_IN = 5632, SW_V = 7680, SW_GU2 = 8192;

__device__ __forceinline__ unsigned cvtpk(float lo, float hi) { f32x2_t v = {lo, hi}; bf16x2_t b = __builtin_convertvector(v, bf16x2_t); return __builtin_bit_cast(unsigned, b); }
typedef _Float16 f16x2_t __attribute__((ext_vector_type(2)));
__device__ __forceinline__ unsigned cvtpk_h(float lo, float hi) { f32x2_t v = {lo, hi}; f16x2_t h = __builtin_convertvector(v, f16x2_t); return __builtin_bit_cast(unsigned, h); }
__device__ __forceinline__ f32x2_t unpk_h(unsigned w) { return __builtin_convertvector(__builtin_bit_cast(f16x2_t, w), f32x2_t); }
__device__ __forceinline__ float bf_lo(unsigned w) { return __builtin_bit_cast(float, w << 16); }
__device__ __forceinline__ float bf_hi(unsigned w) { return __builtin_bit_cast(float, w & 0xffff0000u); }

namespace pg8 {
constexpr int BM = 256, BK = 64, HALF = 128, HTB = HALF * BK * 2, STAGE_BYTES = 8 * HTB, NXCD = 8, WGM = 8;
__host__ __device__ __forceinline__ int lds_byte(int r, int c) { const int st = (r >> 4) * 2 + (c >> 5), rr = r & 15, cc = c & 31, ob = rr * 64 + cc * 2; return st * 1024 + (ob ^ (((ob >> 9) & 1) << 5)); }
__host__ __device__ __forceinline__ void stage_rc(int b, int& R, int& C) { const int st = b / 1024, sb = b % 1024, swz = sb ^ (((sb >> 9) & 1) << 5); R = (st >> 1) * 16 + swz / 64; C = (st & 1) * 32 + (swz % 64) / 2; }
__host__ __device__ __forceinline__ int perm32(int rho) { const int n = rho >> 4, i = rho & 15; return 8 * (i >> 2) + 4 * n + (i & 3); }

struct Unit { int pm, pn; };
struct Gemm { const bf16_t* A; const bf16_t* Bt; int M, N, K; };

struct StaticOrder {
    int nM, nN, nwg, G, c;
    __device__ void init(int M, int N, int G_, int c_) { nM = M / BM; nN = N / BM; nwg = nM * nN; G = G_; c = c_; }
    __device__ bool next(int i, Unit& u) const {
        const long L = (long)i * G + c; if (L >= nwg) return false;
        int wgid = (int)L; { const int q = nwg / NXCD, r = nwg % NXCD, xcd = wgid % NXCD, off = wgid / NXCD; wgid = (xcd < r ? xcd * (q + 1) : r * (q + 1) + (xcd - r) * q) + off; }
        const int nig = WGM * nN, gid = wgid / nig, fm = gid * WGM, gsz = (nM - fm) < WGM ? (nM - fm) : WGM;
        u.pm = fm + ((wgid % nig) % gsz); u.pn = (wgid % nig) / gsz; return true;
    }
};

template <int NMc, int NNc> struct StaticOrderC {
    int G, c;
    __device__ void init(int, int, int G_, int c_) { G = G_; c = c_; }
    __device__ bool next(int i, Unit& u) const {
        constexpr int nwg = NMc * NNc, q = nwg / NXCD, r = nwg % NXCD, nig = WGM * NNc;
        const long L = (long)i * G + c; if (L >= nwg) return false;
        int wgid = (int)L; { const int xcd = wgid % NXCD, off = wgid / NXCD; wgid = (xcd < r ? xcd * (q + 1) : r * (q + 1) + (xcd - r) * q) + off; }
        const int gid = wgid / nig, fm = gid * WGM, gsz = (NMc % WGM == 0) ? WGM : ((NMc - fm) < WGM ? (NMc - fm) : WGM);
        u.pm = fm + ((wgid % nig) % gsz); u.pn = (wgid % nig) / gsz; return true;
    }
};


struct PreNorm { f32x4 st; float sw; };
__device__ __forceinline__ PreNorm prenorm_load(const float* stats, int row0, const float* swp, int tid) {
    PreNorm p; p.st = (f32x4){0.f, 0.f, 0.f, 0.f}; p.sw = 0.f;
    if (tid < 256) { p.st = *(const f32x4*)(stats + (size_t)(row0 + tid) * 4); p.sw = swp[tid]; }
    return p;
}
__device__ __forceinline__ void prenorm_commit(const PreNorm& p, LAS float* scr, int tid) {
    if (tid < 256) { scr[tid] = rsqrtf(((p.st[0] + p.st[1]) + (p.st[2] + p.st[3])) * (1.0f / DM) + EPS); scr[256 + tid] = p.sw; }
    asm volatile("s_waitcnt lgkmcnt(0)" ::: "memory"); __builtin_amdgcn_s_barrier(); asm volatile("" ::: "memory");
}

struct EpiVt {
    static constexpr bool PERM = true;
    bf16_t* O; const float* stats; const float* sW; LAS float* scr;
    typedef PreNorm Pre;
    __device__ __forceinline__ Pre prefetch(const Unit& u, int tid) const { return prenorm_load(stats, u.pn * BM, sW + (size_t)(u.pn >> 4) * SW_ROWS + u.pm * BM, tid); }
    __device__ __forceinline__ void operator()(const f32x4 (&acc)[2][2][4][2], const Unit& u, int wr, int wc, int fr, int fq, int tid, const Pre& pre) const {
        prenorm_commit(pre, scr, tid);
        const int row0 = u.pm * BM + wr * 64 + fr; const int col0 = u.pn * BM + wc * 32 + 8 * fq;
        f32x4 rs[2][2];
#pragma unroll
        for (int bj = 0; bj < 2; ++bj)
#pragma unroll
            for (int n = 0; n < 2; ++n) rs[bj][n] = *(const LAS f32x4*)(scr + bj * HALF + wc * 32 + 8 * fq + 4 * n);
#pragma unroll
        for (int ai = 0; ai < 2; ++ai)
#pragma unroll
            for (int m = 0; m < 4; ++m) { const int row = row0 + ai * HALF + m * 16; bf16_t* rowp = O + (size_t)row * MTOK + col0;
                const float sh = scr[256 + ai * HALF + wr * 64 + m * 16 + fr];
#pragma unroll
                for (int bj = 0; bj < 2; ++bj) { const f32x4 v0 = acc[ai][bj][m][0] * rs[bj][0] + sh, v1 = acc[ai][bj][m][1] * rs[bj][1] + sh;
                    u32x4 w; w.x = cvtpk(v0[0], v0[1]); w.y = cvtpk(v0[2], v0[3]); w.z = cvtpk(v1[0], v1[1]); w.w = cvtpk(v1[2], v1[3]);
                    *(u32x4*)(rowp + bj * HALF) = w; } }
    }
};

__device__ __forceinline__ float silu2(float g2, float u2) { return (g2 * u2) * __builtin_amdgcn_rcpf(1.0f + __builtin_amdgcn_exp2f(g2)); }
__device__ __forceinline__ float silu_mul(float g, float u) { return g * __builtin_amdgcn_rcpf(1.0f + __builtin_amdgcn_exp2f(-g * LOG2E)) * u; }
struct EpiSwiGLU {
    static constexpr bool PERM = true;
    bf16_t* O; const float* stats; const float* sW; LAS float* scr;
    typedef PreNorm Pre;
    __device__ __forceinline__ Pre prefetch(const Unit& u, int tid) const { return prenorm_load(stats, u.pm * BM, sW + (size_t)(u.pm >> 4) * SW_ROWS + u.pn * BM, tid); }
    __device__ __forceinline__ void operator()(const f32x4 (&acc)[2][2][4][2], const Unit& u, int wr, int wc, int fr, int fq, int tid, const Pre& pre) const {
        prenorm_commit(pre, scr, tid);
        const int row0 = u.pm * BM + wr * 64 + fr; const int col0 = u.pn * HALF + wc * 32 + 8 * fq;
        const LAS float* sp = scr + 256 + wc * 32 + 8 * fq;
        const f32x4 sg0 = *(const LAS f32x4*)sp * (-LOG2E), sg1 = *(const LAS f32x4*)(sp + 4) * (-LOG2E), su0 = *(const LAS f32x4*)(sp + HALF) * (-1.0f / LOG2E), su1 = *(const LAS f32x4*)(sp + HALF + 4) * (-1.0f / LOG2E);
#pragma unroll
        for (int ai = 0; ai < 2; ++ai)
#pragma unroll
            for (int m = 0; m < 4; ++m) { bf16_t* rowp = O + (size_t)(row0 + ai * HALF + m * 16) * FF + col0;
                const float rs = scr[ai * HALF + wr * 64 + m * 16 + fr]; const float rsg = rs * (-LOG2E), rsu = rs * (-1.0f / LOG2E);
                const f32x4 g0 = acc[ai][0][m][0] * rsg + sg0, g1 = acc[ai][0][m][1] * rsg + sg1, u0 = acc[ai][1][m][0] * rsu + su0, u1 = acc[ai][1][m][1] * rsu + su1;
                u32x4 w; w.x = cvtpk(silu2(g0[0], u0[0]), silu2(g0[1], u0[1])); w.y = cvtpk(silu2(g0[2], u0[2]), silu2(g0[3], u0[3]));
                w.z = cvtpk(silu2(g1[0], u1[0]), silu2(g1[1], u1[1])); w.w = cvtpk(silu2(g1[2], u1[2]), silu2(g1[3], u1[3]));
                *(u32x4*)rowp = w; }
    }
};

struct EpiRes {
    static constexpr bool PERM = true;
    const bf16_t* base; bf16_t* xb; float* out; const float* gate;
    bf16_t* XT; const float* gain_n; const float* scale_n; float* stats; LAS float* scr; float coef;
    struct Pre { float gv, gsn; };
    __device__ __forceinline__ Pre prefetch(const Unit& u, int tid) const {
        Pre p; p.gv = 0.f; p.gsn = 0.f;
        if (tid < 256) { const int b = u.pm >> 4, col = u.pn * BM + tid;
            p.gv = (gate[(size_t)b * NMOD + col] + 1.0f) * coef;
            if (XT != nullptr) p.gsn = gain_n[col] * (scale_n[(size_t)b * NMOD + col] + 1.0f); }
        return p;
    }
    __device__ __forceinline__ void operator()(const f32x4 (&acc)[2][2][4][2], const Unit& u, int wr, int wc, int fr, int fq, int tid, const Pre& pre) const {
        const int row0 = u.pm * BM + wr * 64 + fr; const int col0 = u.pn * BM + wc * 32 + 8 * fq;
        const bool nx = (XT != nullptr);
        u32x4 bw[4][2][2];
#define RES_LOAD(q) do { _Pragma("unroll") for (int mm = 0; mm < 2; ++mm) _Pragma("unroll") for (int bj = 0; bj < 2; ++bj) \
            bw[q][mm][bj] = __builtin_nontemporal_load((const u32x4*)(base + (size_t)(row0 + ((q) >> 1) * HALF + (((q) & 1) * 2 + mm) * 16) * DM + col0 + bj * HALF)); asm volatile("" ::: "memory"); } while (0)
        RES_LOAD(0);
        LAS float* tb = scr + 1024;
        if (tid < 256) { tb[tid] = pre.gv; tb[256 + tid] = pre.gsn; }
        asm volatile("s_waitcnt lgkmcnt(0)" ::: "memory"); __builtin_amdgcn_s_barrier(); asm volatile("" ::: "memory");
        f32x4 gv[2][2], gsn[2][2];
#pragma unroll
        for (int bj = 0; bj < 2; ++bj)
#pragma unroll
            for (int n = 0; n < 2; ++n) { gv[bj][n] = *(const LAS f32x4*)(tb + bj * HALF + wc * 32 + 8 * fq + 4 * n); gsn[bj][n] = *(const LAS f32x4*)(tb + 256 + bj * HALF + wc * 32 + 8 * fq + 4 * n); }
        RES_LOAD(1);
#pragma unroll
        for (int q = 0; q < 4; ++q) {
            const int ai = q >> 1;
#pragma unroll
            for (int mm = 0; mm < 2; ++mm) { const int m = (q & 1) * 2 + mm; const size_t off = (size_t)(row0 + ai * HALF + m * 16) * DM + col0; float ss = 0.f;
#pragma unroll
                for (int bj = 0; bj < 2; ++bj) {
                    const f32x2_t h0 = unpk_h(bw[q][mm][bj].x), h1 = unpk_h(bw[q][mm][bj].y), h2 = unpk_h(bw[q][mm][bj].z), h3 = unpk_h(bw[q][mm][bj].w);
                    const f32x4 b0 = {h0[0], h0[1], h1[0], h1[1]}, b1 = {h2[0], h2[1], h3[0], h3[1]};
                    const f32x4 o0 = b0 + gv[bj][0] * acc[ai][bj][m][0], o1 = b1 + gv[bj][1] * acc[ai][bj][m][1];
                    if (nx) { ss += ((o0[0] * o0[0] + o0[1] * o0[1]) + (o0[2] * o0[2] + o0[3] * o0[3])) + ((o1[0] * o1[0] + o1[1] * o1[1]) + (o1[2] * o1[2] + o1[3] * o1[3]));
                        u32x4 xw; xw.x = cvtpk_h(o0[0], o0[1]); xw.y = cvtpk_h(o0[2], o0[3]); xw.z = cvtpk_h(o1[0], o1[1]); xw.w = cvtpk_h(o1[2], o1[3]);
                        __builtin_nontemporal_store(xw, (u32x4*)(xb + off + bj * HALF));
                        const f32x4 t0 = o0 * gsn[bj][0], t1 = o1 * gsn[bj][1];
                        u32x4 w; w.x = cvtpk(t0[0], t0[1]); w.y = cvtpk(t0[2], t0[3]); w.z = cvtpk(t1[0], t1[1]); w.w = cvtpk(t1[2], t1[3]);
                        *(u32x4*)(XT + off + bj * HALF) = w; }
                    else { *(f32x4*)(out + off + bj * HALF) = o0; *(f32x4*)(out + off + bj * HALF + 4) = o1; } }
                if (nx) { ss += __shfl_xor(ss, 16); ss += __shfl_xor(ss, 32); if (fq == 0) scr[(ai * HALF + wr * 64 + m * 16 + fr) * 4 + wc] = ss; } }
            if (q == 0) RES_LOAD(2); else if (q == 1) RES_LOAD(3); else asm volatile("" ::: "memory");
        }
#undef RES_LOAD
        if (nx) {
            asm volatile("s_waitcnt lgkmcnt(0)" ::: "memory"); __builtin_amdgcn_s_barrier(); asm volatile("" ::: "memory");
            if (tid < 256) { const f32x4 p = *(const LAS f32x4*)(scr + tid * 4); stats[(size_t)(u.pm * BM + tid) * 4 + u.pn] = (p[0] + p[1]) + (p[2] + p[3]); }
        }
    }
};

struct EpiIn {
    static constexpr bool PERM = true;
    bf16_t* O; const float* qg; const float* kg; const float* stats; const float* sW; LAS float* scr;
    typedef PreNorm Pre;
    __device__ __forceinline__ Pre prefetch(const Unit& u, int tid) const { return prenorm_load(stats, u.pm * BM, sW + (size_t)(u.pm >> 4) * SW_ROWS + u.pn * BM, tid); }
    __device__ __forceinline__ void operator()(f32x4 (&acc)[2][2][4][2], const Unit& u, int wr, int wc, int fr, int fq, int tid, const Pre& pre) const {
        prenorm_commit(pre, scr, tid);
        const int row0 = u.pm * BM + wr * 64 + fr;
        f32x4 sv[2][2];
#pragma unroll
        for (int bj = 0; bj < 2; ++bj)
#pragma unroll
            for (int n = 0; n < 2; ++n) sv[bj][n] = *(const LAS f32x4*)(scr + 256 + bj * HALF + wc * 32 + 8 * fq + 4 * n);
        if (u.pn < 4) {
            const float* gn = (u.pn < 2) ? qg : kg; const float sc = (u.pn < 2) ? QSCALE : 1.0f;
            f32x4 gv[2][2];
#pragma unroll
            for (int bj = 0; bj < 2; ++bj)
#pragma unroll
                for (int n = 0; n < 2; ++n) gv[bj][n] = *(const f32x4*)(gn + 32 * bj + 8 * fq + 4 * n) * sc;
            const int col0 = u.pn * BM + wc * 64 + 8 * fq;
#pragma unroll
            for (int ai = 0; ai < 2; ++ai)
#pragma unroll
                for (int m = 0; m < 4; ++m) {
                    const float rsn = scr[ai * HALF + wr * 64 + m * 16 + fr];
                    f32x4 x[2][2]; float ss = 0.f;
#pragma unroll
                    for (int bj = 0; bj < 2; ++bj)
#pragma unroll
                        for (int n = 0; n < 2; ++n) { x[bj][n] = acc[ai][bj][m][n] * rsn + sv[bj][n]; ss += (x[bj][n][0] * x[bj][n][0] + x[bj][n][1] * x[bj][n][1]) + (x[bj][n][2] * x[bj][n][2] + x[bj][n][3] * x[bj][n][3]); }
                    ss += __shfl_xor(ss, 16); ss += __shfl_xor(ss, 32);
                    const float rs = rsqrtf(ss * (1.0f / 64.0f) + EPS);
                    bf16_t* rowp = O + (size_t)(row0 + ai * HALF + m * 16) * PW + col0;
#pragma unroll
                    for (int bj = 0; bj < 2; ++bj) { const f32x4 v0 = x[bj][0] * rs * gv[bj][0], v1 = x[bj][1] * rs * gv[bj][1];
                        u32x4 w; w.x = cvtpk(v0[0], v0[1]); w.y = cvtpk(v0[2], v0[3]); w.z = cvtpk(v1[0], v1[1]); w.w = cvtpk(v1[2], v1[3]);
                        *(u32x4*)(rowp + 32 * bj) = w; }
                }
        } else {
            const int col0 = u.pn * BM + wc * 32 + 8 * fq;
#pragma unroll
            for (int ai = 0; ai < 2; ++ai)
#pragma unroll
                for (int m = 0; m < 4; ++m) { bf16_t* rowp = O + (size_t)(row0 + ai * HALF + m * 16) * PW + col0;
                    const float rsn = scr[ai * HALF + wr * 64 + m * 16 + fr];
#pragma unroll
                    for (int bj = 0; bj < 2; ++bj) { const f32x4 v0 = acc[ai][bj][m][0] * rsn + sv[bj][0], v1 = acc[ai][bj][m][1] * rsn + sv[bj][1];
                        u32x4 w; w.x = cvtpk(v0[0], v0[1]); w.y = cvtpk(v0[2], v0[3]); w.z = cvtpk(v1[0], v1[1]); w.w = cvtpk(v1[2], v1[3]);
                        *(u32x4*)(rowp + bj * HALF) = w; } }
        }
    }
};

template <class Epi, class Sched>
__device__ __forceinline__ void gemm_phase(LAS unsigned char* lds, const Gemm g, const Sched& S, const Epi& E, const int tid) {
    const int wid = __builtin_amdgcn_readfirstlane(tid >> 6), lane = tid & 63, wr = wid >> 2, wc = wid & 3, fr = lane & 15, fq = lane >> 4;
    const int K = g.K, nt = K / BK;
    unsigned voffA[2], voffB[2];
#pragma unroll
    for (int i = 0; i < 2; ++i) { int R, C; stage_rc(tid * 16 + i * 8192, R, C); const int Rb = Epi::PERM ? ((R & ~31) + perm32(R & 31)) : R;
        voffA[i] = (unsigned)(R * K + C) * 2u; voffB[i] = (unsigned)(Rb * K + C) * 2u; }
    const size_t kstep = (size_t)(BK * 2);
    const size_t hstep = (size_t)HALF * K * 2;
    const size_t tstep = 2 * hstep;
    const unsigned ldsw = (unsigned)wid * 1024u;
    const int aoff = lds_byte(wr * 64 + fr, fq * 8), boff = lds_byte(wc * 32 + fr, fq * 8);
#define PG8_SA(b, h) (((b) * 2 + (h)) * HTB)
#define PG8_SB(b, h) ((4 + (b) * 2 + (h)) * HTB)
#define PG8_STAGE(bufoff, gbase, voff) do { _Pragma("unroll") for (int _i = 0; _i < 2; ++_i) \
        __builtin_amdgcn_global_load_lds((const unsigned*)((const char*)(gbase) + (voff)[_i]), (LAS unsigned*)(lds + (bufoff) + ldsw + _i * 8192), 16, 0, 0); } while (0)
#define PG8_LDA(dst, b, h) do { _Pragma("unroll") for (int m = 0; m < 4; ++m) _Pragma("unroll") for (int k = 0; k < 2; ++k) dst[m][k] = *(const LAS bf16x8*)(lds + PG8_SA(b, h) + aoff + m * 2048 + k * 1024); } while (0)
#define PG8_LDB(dst, b, h) do { _Pragma("unroll") for (int n = 0; n < 2; ++n) _Pragma("unroll") for (int k = 0; k < 2; ++k) dst[n][k] = *(const LAS bf16x8*)(lds + PG8_SB(b, h) + boff + n * 2048 + k * 1024); } while (0)
#define PG8_MMA(ai, bj, At, Bt) do { __builtin_amdgcn_s_setprio(1); _Pragma("unroll") for (int m = 0; m < 4; ++m) _Pragma("unroll") for (int n = 0; n < 2; ++n) _Pragma("unroll") for (int k = 0; k < 2; ++k) \
        acc[ai][bj][m][n] = __builtin_amdgcn_mfma_f32_16x16x32_bf16(Bt[n][k], At[m][k], acc[ai][bj][m][n], 0, 0, 0); __builtin_amdgcn_s_setprio(0); } while (0)
#define PG8_WAIT_V(n) asm volatile("s_waitcnt vmcnt(" #n ")" ::: "memory")
#define PG8_WAIT_L(n) asm volatile("s_waitcnt lgkmcnt(" #n ")" ::: "memory")
#define PG8_BAR __builtin_amdgcn_s_barrier()
#define PG8_SCHED __builtin_amdgcn_sched_barrier(0)
    Unit cur, nxt; int ui = 0;
    if (!S.next(0, cur)) return;
    f32x4 acc[2][2][4][2];
#pragma unroll
    for (int a = 0; a < 2; ++a)
#pragma unroll
        for (int b = 0; b < 2; ++b)
#pragma unroll
            for (int m = 0; m < 4; ++m)
#pragma unroll
                for (int n = 0; n < 2; ++n) acc[a][b][m][n] = (f32x4){0.f, 0.f, 0.f, 0.f};
    bf16x8 At[4][2], B0[2][2], B1[2][2];
    const char* cA = (const char*)g.A + (size_t)cur.pm * tstep; const char* cB = (const char*)g.Bt + (size_t)cur.pn * tstep;
    PG8_STAGE(PG8_SB(0, 0), cB, voffB); PG8_STAGE(PG8_SB(0, 1), cB + hstep, voffB); PG8_STAGE(PG8_SA(0, 0), cA, voffA); PG8_STAGE(PG8_SA(0, 1), cA + hstep, voffA);
    if (wr == 1) PG8_BAR;
    PG8_WAIT_V(2); PG8_BAR;
    PG8_STAGE(PG8_SB(1, 0), cB + kstep, voffB); PG8_STAGE(PG8_SA(1, 0), cA + kstep, voffA); PG8_STAGE(PG8_SB(1, 1), cB + hstep + kstep, voffB);
    PG8_WAIT_V(6); PG8_BAR;
    for (;;) {
        const bool has_next = S.next(ui + 1, nxt);
        const char* nA = has_next ? (const char*)g.A + (size_t)nxt.pm * tstep : cA; const char* nB = has_next ? (const char*)g.Bt + (size_t)nxt.pn * tstep : cB;
        const typename Epi::Pre pre = E.prefetch(cur, tid);
        for (int t = 0; t < nt; t += 2) {
            const bool last = (t == nt - 2);
            const char* a1 = cA + (size_t)(t + 1) * kstep;
            const char* a2 = last ? nA : cA + (size_t)(t + 2) * kstep; const char* b2 = last ? nB : cB + (size_t)(t + 2) * kstep;
            const char* a3 = a2 + kstep; const char* b3 = b2 + kstep;
            PG8_LDB(B0, 0, 0); PG8_LDB(B1, 0, 1); PG8_SCHED; PG8_LDA(At, 0, 0); PG8_STAGE(PG8_SA(1, 1), a1 + hstep, voffA);
            PG8_WAIT_V(8); PG8_WAIT_L(0); PG8_BAR; PG8_MMA(0, 0, At, B0); PG8_MMA(0, 1, At, B1); PG8_BAR; PG8_SCHED;
            PG8_LDA(At, 0, 1); PG8_STAGE(PG8_SB(0, 0), b2, voffB); PG8_STAGE(PG8_SB(0, 1), b2 + hstep, voffB); PG8_STAGE(PG8_SA(0, 0), a2, voffA);
            PG8_WAIT_V(8); PG8_WAIT_L(0); PG8_BAR; PG8_MMA(1, 0, At, B0); PG8_MMA(1, 1, At, B1); PG8_BAR; PG8_SCHED;
            PG8_LDB(B0, 1, 0); PG8_LDB(B1, 1, 1); PG8_SCHED; PG8_LDA(At, 1, 0); PG8_STAGE(PG8_SA(0, 1), a2 + hstep, voffA);
            PG8_WAIT_V(8); PG8_WAIT_L(0); PG8_BAR; PG8_MMA(0, 0, At, B0); PG8_MMA(0, 1, At, B1); PG8_BAR; PG8_SCHED;
            PG8_LDA(At, 1, 1); PG8_STAGE(PG8_SB(1, 0), b3, voffB); PG8_STAGE(PG8_SB(1, 1), b3 + hstep, voffB); PG8_STAGE(PG8_SA(1, 0), a3, voffA);
            PG8_WAIT_V(8); PG8_WAIT_L(0); PG8_BAR; PG8_MMA(1, 0, At, B0); PG8_MMA(1, 1, At, B1); PG8_BAR; PG8_SCHED;
        }
        if (wr == 0) PG8_BAR;
        E(acc, cur, wr, wc, fr, fq, tid, pre);
        if (!has_next) break;
#pragma unroll
        for (int a = 0; a < 2; ++a)
#pragma unroll
            for (int b = 0; b < 2; ++b)
#pragma unroll
                for (int m = 0; m < 4; ++m)
#pragma unroll
                    for (int n = 0; n < 2; ++n) acc[a][b][m][n] = (f32x4){0.f, 0.f, 0.f, 0.f};
        cur = nxt; cA = nA; cB = nB; ++ui;
        if (wr == 1) PG8_BAR;
    }
    PG8_WAIT_V(0);
    PG8_BAR;
#undef PG8_SA
#undef PG8_SB
#undef PG8_STAGE
#undef PG8_LDA
#undef PG8_LDB
#undef PG8_MMA
#undef PG8_WAIT_V
#undef PG8_WAIT_L
#undef PG8_BAR
#undef PG8_SCHED
}
}

#define XB_TMO      128
#define XB_XCNT(j)  (256  + 64 * (j))
#define XB_XSUB(j)  (1280 + 64 * (j))
#define XB_XGEN(j)  (2304 + 64 * (j))
#define XB_TOP      3328
#define XB_TOPGEN   3392
#define XCD_BAR_WORDS 3456
#define XB_SPIN_CAP (1u << 22)
__device__ __forceinline__ unsigned xb_ld(unsigned* p)              { return __hip_atomic_load(p, __ATOMIC_RELAXED, __HIP_MEMORY_SCOPE_AGENT); }
__device__ __forceinline__ unsigned xb_add(unsigned* p, unsigned v) { return __hip_atomic_fetch_add(p, v, __ATOMIC_RELAXED, __HIP_MEMORY_SCOPE_AGENT); }
__device__ __forceinline__ unsigned xb_xcc_id() { return (unsigned)__builtin_amdgcn_s_getreg((3 << 11) | 20) & 0xFu; }
#define XB_SPIN(cond, bar) do { unsigned _sp = 0; while (cond) { __builtin_amdgcn_s_sleep(1); \
    if ((++_sp & 255u) == 0u) { if (xb_ld(&(bar)[XB_TMO])) break; if (_sp > XB_SPIN_CAP) { atomicAdd(&(bar)[XB_TMO], 1u); break; } } } } while (0)
struct XcdBarrier { unsigned* bar; unsigned x; volatile LAS unsigned* st; };
__device__ __forceinline__ bool is_thread0(int wave0) { return wave0 == 0 && __builtin_amdgcn_mbcnt_hi(~0u, __builtin_amdgcn_mbcnt_lo(~0u, 0u)) == 0u; }
__device__ __forceinline__ XcdBarrier xcd_barrier_post(unsigned* bar, volatile LAS unsigned* st, int wave0) {
    XcdBarrier b; b.bar = bar; b.x = xb_xcc_id(); b.st = st;
    if (is_thread0(wave0)) (void)xb_add(&bar[XB_XCNT(b.x)], 1u);
    return b;
}
__device__ __forceinline__ void xcd_barrier_complete(unsigned* bar, unsigned x, unsigned& nloc, unsigned& nx) {
    const unsigned G = gridDim.x * gridDim.y * gridDim.z;
    unsigned sum, cnt, mine, sp = 0u;
    for (;;) {
        sum = 0u; cnt = 0u; mine = 0u;
#pragma unroll
        for (unsigned j = 0; j < 16; ++j) { const unsigned c = xb_ld(&bar[XB_XCNT(j)]); sum += c; cnt += (c > 0u) ? 1u : 0u; mine = (j == x) ? c : mine; }
        if (sum == G) break;
        __builtin_amdgcn_s_sleep(1);
        if ((++sp & 255u) == 0u) { if (xb_ld(&bar[XB_TMO])) break; if (sp > XB_SPIN_CAP) { atomicAdd(&bar[XB_TMO], 1u); break; } }
    }
    nloc = mine > 0u ? mine : 1u; nx = cnt > 0u ? cnt : 1u;
}
__device__ __forceinline__ void xcd_barrier(const XcdBarrier& b, int wave0) {
    asm volatile("s_waitcnt vmcnt(0)" ::: "memory");
    __syncthreads();
    if (is_thread0(wave0)) {
        unsigned* bar = b.bar;
        __builtin_amdgcn_s_waitcnt(0);
        unsigned nloc = b.st[0], nx = b.st[1];
        if (nloc == 0u) { xcd_barrier_complete(bar, b.x, nloc, nx); b.st[0] = nloc; b.st[1] = nx; }
        const unsigned old = xb_add(&bar[XB_XSUB(b.x)], 1u);
        const unsigned gen = old / nloc;
        if (old + 1u == (gen + 1u) * nloc) {
            __builtin_amdgcn_fence(__ATOMIC_RELEASE, "agent");
            asm volatile("s_waitcnt vmcnt(0)" ::: "memory");
            const unsigned og = xb_add(&bar[XB_TOP], 1u);
            const unsigned tg = og / nx;
            if (og + 1u == (tg + 1u) * nx) xb_add(&bar[XB_TOPGEN], 1u);
            else XB_SPIN(xb_ld(&bar[XB_TOPGEN]) == tg, bar);
            __builtin_amdgcn_fence(__ATOMIC_ACQUIRE, "agent");
            xb_add(&bar[XB_XGEN(b.x)], 1u);
            asm volatile("s_waitcnt vmcnt(0)" ::: "memory");
        } else {
            XB_SPIN(xb_ld(&bar[XB_XGEN(b.x)]) == gen, bar);
            __builtin_amdgcn_fence(__ATOMIC_ACQUIRE, "agent");
            asm volatile("s_waitcnt vmcnt(0)" ::: "memory");
        }
    }
    __syncthreads();
}

struct Args { const float* in[20]; float* out; unsigned char* ws; int lo, hi; };

__device__ __forceinline__ float wave_sum(float v) {
#pragma unroll
    for (int o = 1; o < 64; o <<= 1) v += __shfl_xor(v, o);
    return v;
}

__device__ __forceinline__ void transpose_item(const float* W, int ldw, int s0, int k0, bf16_t* WT, int ldt, int j0, LAS float* scr, int lane) {
    const int kr = lane >> 3, c4 = (lane & 7) * 4;
    f32x4 v[8];
#pragma unroll
    for (int i = 0; i < 8; ++i) v[i] = __builtin_nontemporal_load((const f32x4*)(W + (size_t)(k0 + 8 * i + kr) * ldw + s0 + c4));
#pragma unroll
    for (int i = 0; i < 8; ++i) { LAS float* d = scr + (8 * i + kr) * 33 + c4; d[0] = v[i][0]; d[1] = v[i][1]; d[2] = v[i][2]; d[3] = v[i][3]; }
    asm volatile("s_waitcnt lgkmcnt(0)" ::: "memory");
    const int c = lane & 7;
#pragma unroll
    for (int j = 0; j < 4; ++j) { const int n = (lane >> 3) + 8 * j; const LAS float* s = scr + (8 * c) * 33 + n;
        u32x4 o; o.x = cvtpk(s[0 * 33], s[1 * 33]); o.y = cvtpk(s[2 * 33], s[3 * 33]); o.z = cvtpk(s[4 * 33], s[5 * 33]); o.w = cvtpk(s[6 * 33], s[7 * 33]);
        *(u32x4*)(WT + (size_t)(j0 + n) * ldt + k0 + 8 * c) = o; }
    asm volatile("s_waitcnt lgkmcnt(0)" ::: "memory");
}

constexpr int I_GU = 16 * 176, I_D = 44 * 32, I_IN = 16 * 56, I_V = 16 * 16, I_O = 16 * 32, I_LAYER = 2 * I_GU + 2 * I_D + I_IN + I_V + I_O;

__device__ __forceinline__ void prologue(const Args& a, LAS unsigned char* lds, int tid, int lane, int wave, int gw, int NGW) {
    unsigned char* ws = a.ws;
    float* mod = (float*)(ws + WS_MOD);
    bf16_t* Wgu = (bf16_t*)(ws + WS_WGU); bf16_t* Wd = (bf16_t*)(ws + WS_WD); bf16_t* Win = (bf16_t*)(ws + WS_WIN); bf16_t* Wv = (bf16_t*)(ws + WS_WV); bf16_t* Wout = (bf16_t*)(ws + WS_WOUT);
    {
        LAS float* condt = (LAS float*)lds; LAS float* red = condt + 8192;
        const float* c = a.in[1];
        for (int i = tid; i < 8192; i += 512) { const int b = i >> 10, k = i & 1023; const float v = c[i]; condt[k * 8 + b] = v / (1.0f + __expf(-v)); }
        __syncthreads();
        for (int item = blockIdx.x; item < NL * 64; item += gridDim.x) {
            const int l = item >> 6, col0 = (item & 63) * 144;
            f32x4 acc[8];
#pragma unroll
            for (int b = 0; b < 8; ++b) acc[b] = (f32x4){0.f, 0.f, 0.f, 0.f};
            if (lane < 36) {
                const float* wp = a.in[2] + ((size_t)l * 1024 + wave * 128) * NMOD + col0 + 4 * lane;
#pragma unroll 8
                for (int kk = 0; kk < 128; ++kk) { const f32x4 wv = __builtin_nontemporal_load((const f32x4*)(wp + (size_t)kk * NMOD));
                    const f32x4 c0 = *(const LAS f32x4*)(condt + (wave * 128 + kk) * 8), c1 = *(const LAS f32x4*)(condt + (wave * 128 + kk) * 8 + 4);
                    acc[0] += wv * c0[0]; acc[1] += wv * c0[1]; acc[2] += wv * c0[2]; acc[3] += wv * c0[3]; acc[4] += wv * c1[0]; acc[5] += wv * c1[1]; acc[6] += wv * c1[2]; acc[7] += wv * c1[3]; }
#pragma unroll
                for (int b = 0; b < 8; ++b) *(LAS f32x4*)(red + (wave * 8 + b) * 144 + 4 * lane) = acc[b];
            }
            __syncthreads();
            for (int o = tid; o < 8 * 144; o += 512) { const int b = o / 144, n = o % 144; float sm = 0.f;
#pragma unroll
                for (int w = 0; w < 8; ++w) sm += red[(w * 8 + b) * 144 + n];
                mod[((size_t)l * 8 + b) * NMOD + col0 + n] = sm + a.in[3][(size_t)l * NMOD + col0 + n]; }
            __syncthreads();
        }
    }
    {
        LAS float* scr = (LAS float*)(lds + wave * 16384);
        for (int it = gw; it < NL * I_LAYER; it += NGW) {
            const int l = it / I_LAYER; int r = it % I_LAYER;
            const float* W; int ldw, s0, k0, ldt, j0; bf16_t* WT;
            if (r < 2 * I_GU) { const int f = r / I_GU; r %= I_GU; const int kb = r / 176, nb = r % 176; j0 = nb * 32; k0 = kb * 64;
                const float* gate = f ? a.in[17] : a.in[5]; const float* up = f ? a.in[18] : a.in[6];
                W = ((j0 & 128) ? up : gate) + (size_t)l * DM * FF; ldw = FF; s0 = 128 * (j0 >> 8) + (j0 & 127);
                WT = Wgu + (size_t)(l * 2 + f) * 5632 * 1024; ldt = 1024; }
            else if ((r -= 2 * I_GU) < 2 * I_D) { const int f = r / I_D; r %= I_D; const int kb = r / 32, nb = r % 32; j0 = nb * 32; k0 = kb * 64;
                W = (f ? a.in[19] : a.in[7]) + (size_t)l * FF * DM; ldw = DM; s0 = j0; WT = Wd + (size_t)(l * 2 + f) * 1024 * FF; ldt = FF; }
            else if ((r -= 2 * I_D) < I_IN) { const int kb = r / 56, nb = r % 56; j0 = nb * 32; k0 = kb * 64; W = a.in[9] + (size_t)l * DM * 2560; ldw = 2560;
                s0 = (j0 < 1024) ? (256 * (j0 >> 8) + 64 * ((j0 >> 5) & 3) + 32 * ((j0 >> 7) & 1)) : (j0 + 512);
                WT = Win + (size_t)l * 2048 * 1024; ldt = 1024; }
            else if ((r -= I_IN) < I_V) { const int kb = r / 16, nb = r % 16; j0 = nb * 32; k0 = kb * 64; W = a.in[9] + (size_t)l * DM * 2560; ldw = 2560; s0 = 1024 + j0;
                WT = Wv + (size_t)l * 512 * 1024; ldt = 1024; }
            else { r -= I_V; const int kb = r / 32, nb = r % 32; j0 = nb * 32; k0 = kb * 64; W = a.in[15] + (size_t)l * DM * DM; ldw = DM; s0 = j0;
                WT = Wout + (size_t)l * 1024 * 1024; ldt = 1024; }
            transpose_item(W, ldw, s0, k0, WT, ldt, j0, scr, lane);
        }
    }
    for (int it = gw; it < NL * 4 * 128; it += NGW) {
        const int l = it >> 9, g = (it >> 7) & 3, k0 = (it & 127) * 8, d = lane;
        const float* wi = a.in[9] + ((size_t)l * DM + k0) * 2560 + 2304 + g * 64;
        const float* pw = a.in[13] + ((size_t)(l * 4 + g) * 64) * 64 + d;
        float acc[8];
#pragma unroll
        for (int i = 0; i < 8; ++i) acc[i] = 0.f;
#pragma unroll 4
        for (int c = 0; c < 64; ++c) { const float p = pw[c * 64];
#pragma unroll
            for (int i = 0; i < 8; ++i) acc[i] += wi[(size_t)i * 2560 + c] * p; }
        const float ps = a.in[14][l * 256 + g * 64 + d];
        u32x4 o; o.x = cvtpk(acc[0] * ps, acc[1] * ps); o.y = cvtpk(acc[2] * ps, acc[3] * ps); o.z = cvtpk(acc[4] * ps, acc[5] * ps); o.w = cvtpk(acc[6] * ps, acc[7] * ps);
        *(u32x4*)(Win + ((size_t)l * 2048 + 1792 + g * 64 + d) * 1024 + k0) = o;
    }
}

__device__ __forceinline__ void sw_rows(const bf16_t* Bt, int nrows, const float* shift, float* sW, int gw, int NGW, int lane) {
    float sh[8][16];
#pragma unroll
    for (int b = 0; b < 8; ++b)
#pragma unroll
        for (int j = 0; j < 2; ++j) { const f32x4 a0 = *(const f32x4*)(shift + (size_t)b * NMOD + j * 512 + 8 * lane), a1 = *(const f32x4*)(shift + (size_t)b * NMOD + j * 512 + 8 * lane + 4);
            sh[b][8 * j + 0] = a0[0]; sh[b][8 * j + 1] = a0[1]; sh[b][8 * j + 2] = a0[2]; sh[b][8 * j + 3] = a0[3]; sh[b][8 * j + 4] = a1[0]; sh[b][8 * j + 5] = a1[1]; sh[b][8 * j + 6] = a1[2]; sh[b][8 * j + 7] = a1[3]; }
    for (int row = gw; row < nrows; row += NGW) {
        const bf16_t* r = Bt + (size_t)row * 1024 + 8 * lane;
        const u32x4 w0 = *(const u32x4*)r, w1 = *(const u32x4*)(r + 512);
        float w[16];
        w[0] = bf_lo(w0.x); w[1] = bf_hi(w0.x); w[2] = bf_lo(w0.y); w[3] = bf_hi(w0.y); w[4] = bf_lo(w0.z); w[5] = bf_hi(w0.z); w[6] = bf_lo(w0.w); w[7] = bf_hi(w0.w);
        w[8] = bf_lo(w1.x); w[9] = bf_hi(w1.x); w[10] = bf_lo(w1.y); w[11] = bf_hi(w1.y); w[12] = bf_lo(w1.z); w[13] = bf_hi(w1.z); w[14] = bf_lo(w1.w); w[15] = bf_hi(w1.w);
        float v = 0.f;
#pragma unroll
        for (int b = 0; b < 8; ++b) { float acc = 0.f;
#pragma unroll
            for (int i = 0; i < 16; ++i) acc += sh[b][i] * w[i];
            acc = wave_sum(acc); v = (lane == b) ? acc : v; }
        if (lane < 8) sW[(size_t)lane * SW_ROWS + row] = v;
    }
}
__device__ __forceinline__ void init_xt(const float* xs, bf16_t* XT, bf16_t* XB, float* stats, const float* gain, const float* scale, int gw, int NGW, int lane) {
    for (int rb = gw; rb < MTOK / 16; rb += NGW) {
        const int row0 = rb * 16, b = row0 >> 12;
        f32x4 gs[4];
#pragma unroll
        for (int j = 0; j < 4; ++j) { const int col = 4 * lane + 256 * j; gs[j] = *(const f32x4*)(gain + col) * (*(const f32x4*)(scale + (size_t)b * NMOD + col) + 1.0f); }
#pragma unroll 2
        for (int i = 0; i < 16; ++i) {
            const float* xr = xs + (size_t)(row0 + i) * DM + 4 * lane;
            f32x4 v[4]; float ss = 0.f;
#pragma unroll
            for (int j = 0; j < 4; ++j) { v[j] = __builtin_nontemporal_load((const f32x4*)(xr + 256 * j)); ss += (v[j][0] * v[j][0] + v[j][1] * v[j][1]) + (v[j][2] * v[j][2] + v[j][3] * v[j][3]); }
            ss = wave_sum(ss);
            if (lane == 0) *(f32x4*)(stats + (size_t)(row0 + i) * 4) = (f32x4){ss, 0.f, 0.f, 0.f};
            bf16_t* hr = XT + (size_t)(row0 + i) * DM + 4 * lane;
#pragma unroll
            for (int j = 0; j < 4; ++j) { const f32x4 o = v[j] * gs[j]; u32x2 w; w.x = cvtpk(o[0], o[1]); w.y = cvtpk(o[2], o[3]); *(u32x2*)(hr + 256 * j) = w; }
            bf16_t* br = XB + (size_t)(row0 + i) * DM + 4 * lane;
#pragma unroll
            for (int j = 0; j < 4; ++j) { u32x2 w; w.x = cvtpk_h(v[j][0], v[j][1]); w.y = cvtpk_h(v[j][2], v[j][3]); *(u32x2*)(br + 256 * j) = w; }
        }
    }
}

constexpr int SB_PITCH = 144, SB_TILE = 64 * SB_PITCH, SB_WAVE_LDS = 2 * SB_TILE;
__device__ __forceinline__ void sb_ldg8(u32x4 (&r)[8], const bf16_t* g, size_t rowstride8) {
#pragma unroll
    for (int j = 0; j < 8; ++j) r[j] = *(const u32x4*)(g + j * rowstride8);
}
__device__ __forceinline__ void sb_attn_wave(const bf16_t* __restrict__ P, const bf16_t* __restrict__ Vt, bf16_t* __restrict__ mixed, int gw, int NGW, int lane, LAS unsigned char* wl) {
    constexpr int NUNITS = NBATCH * 8 * 128;
    const int r32 = lane & 31, hi = lane >> 5;
    const int pi = (r32 & 19) | ((r32 & 4) << 1) | ((r32 & 8) >> 1);
    const int lr = lane >> 3, lp = lane & 7;
    LAS unsigned char* kl = wl; LAS unsigned char* vl = wl + SB_TILE;
    const int wofs = lr * SB_PITCH + lp * 16;
    const int kro = pi * SB_PITCH + hi * 16;
    const int vro = r32 * SB_PITCH + hi * 16;
    int u = gw; if (u >= NUNITS) return;
    size_t tok0; int q0, h, kt; const bf16_t* kg; const bf16_t* vg;
    bf16x8 qf[4]; u32x4 ks[8], vs[8];
#define SB_UNIT_SETUP(uu) do { const int qg_ = (uu) & 127, bh_ = (uu) >> 7; h = bh_ & 7; tok0 = (size_t)(bh_ >> 3) * SEQ; q0 = qg_ * 32; kt = q0 >> 6; \
        const bf16_t* qp_ = P + (tok0 + q0 + r32) * PW + h * 64 + hi * 8; \
        kg = P + (tok0 + lr) * PW + 512 + h * 64 + lp * 8; vg = Vt + (size_t)(h * 64 + lr) * MTOK + tok0 + lp * 8; \
        _Pragma("unroll") for (int d0 = 0; d0 < 4; ++d0) qf[d0] = *(const bf16x8*)(qp_ + d0 * 16); \
        sb_ldg8(ks, kg + (size_t)kt * 64 * PW, (size_t)8 * PW); sb_ldg8(vs, vg + kt * 64, (size_t)8 * MTOK); } while (0)
    SB_UNIT_SETUP(u);
    for (;;) {
        f32x16 o0, o1;
#pragma unroll
        for (int r = 0; r < 16; ++r) { o0[r] = 0.f; o1[r] = 0.f; }
        float carry = 1.0f;
        const int tq = q0 + r32;
        bf16_t* op = mixed + (tok0 + q0 + r32) * DM + h * 64 + 4 * hi;
        for (;;) {
            const int k0 = kt * 64;
#pragma unroll
            for (int j = 0; j < 8; ++j) { *(LAS u32x4*)(kl + wofs + j * 8 * SB_PITCH) = ks[j]; *(LAS u32x4*)(vl + wofs + j * 8 * SB_PITCH) = vs[j]; }
            if (kt > 0) { sb_ldg8(ks, kg + (size_t)(kt - 1) * 64 * PW, (size_t)8 * PW); sb_ldg8(vs, vg + (k0 - 64), (size_t)8 * MTOK); }
            f32x16 p0, p1;
#pragma unroll
            for (int r = 0; r < 16; ++r) { p0[r] = 0.f; p1[r] = 0.f; }
#pragma unroll
            for (int d0 = 0; d0 < 4; ++d0) { const bf16x8 kf0 = *(const LAS bf16x8*)(kl + kro + d0 * 32), kf1 = *(const LAS bf16x8*)(kl + kro + 32 * SB_PITCH + d0 * 32);
                p0 = __builtin_amdgcn_mfma_f32_32x32x16_bf16(kf0, qf[d0], p0, 0, 0, 0); p1 = __builtin_amdgcn_mfma_f32_32x32x16_bf16(kf1, qf[d0], p1, 0, 0, 0); }
            const bool diag = (k0 + 63 >= q0);
            float rr[4][8], G[4];
#pragma unroll
            for (int c = 0; c < 4; ++c) { float gp = 1.0f;
#pragma unroll
                for (int e = 0; e < 8; ++e) { const int idx = (c & 1) * 8 + e; const float t = (c < 2) ? p0[idx] : p1[idx];
                    const float ex = __builtin_amdgcn_exp2f(t); float r = __builtin_amdgcn_rcpf(1.0f + ex); float be = 1.0f - r;
                    if (diag) { const int key = k0 + 16 * c + 8 * hi + e; if (key >= tq) { r = 1.0f; be = 0.f; } }
                    rr[c][e] = r; if (c < 2) p0[idx] = be; else p1[idx] = be; gp *= r; }
                G[c] = gp; }
            float Gp[4], Cin[4];
#pragma unroll
            for (int c = 0; c < 4; ++c) Gp[c] = __shfl_xor(G[c], 32);
            Cin[3] = carry; Cin[2] = Cin[3] * (G[3] * Gp[3]); Cin[1] = Cin[2] * (G[2] * Gp[2]); Cin[0] = Cin[1] * (G[1] * Gp[1]);
            carry = Cin[0] * (G[0] * Gp[0]);
            bf16x8 pb[4];
#pragma unroll
            for (int c = 0; c < 4; ++c) { float run = Cin[c] * (hi == 0 ? Gp[c] : 1.0f); float av[8];
#pragma unroll
                for (int e = 7; e >= 0; --e) { const int idx = (c & 1) * 8 + e; av[e] = ((c < 2) ? p0[idx] : p1[idx]) * run; run *= rr[c][e]; }
                u32x4 w; w.x = cvtpk(av[0], av[1]); w.y = cvtpk(av[2], av[3]); w.z = cvtpk(av[4], av[5]); w.w = cvtpk(av[6], av[7]);
                pb[c] = __builtin_bit_cast(bf16x8, w); }
#pragma unroll
            for (int c = 0; c < 4; ++c) { const bf16x8 vf0 = *(const LAS bf16x8*)(vl + vro + c * 32), vf1 = *(const LAS bf16x8*)(vl + vro + 32 * SB_PITCH + c * 32);
                o0 = __builtin_amdgcn_mfma_f32_32x32x16_bf16(vf0, pb[c], o0, 0, 0, 0); o1 = __builtin_amdgcn_mfma_f32_32x32x16_bf16(vf1, pb[c], o1, 0, 0, 0); }
            if (kt == 0 || __all(carry < 5.421010862427522e-20f)) break;
            --kt;
        }
        const int un = u + NGW; const bool hn = un < NUNITS;
        if (hn) { u = un; SB_UNIT_SETUP(u); }
#pragma unroll
        for (int a = 0; a < 4; ++a) {
            u32x2 w0; w0.x = cvtpk(o0[4 * a], o0[4 * a + 1]); w0.y = cvtpk(o0[4 * a + 2], o0[4 * a + 3]); *(u32x2*)(op + 8 * a) = w0;
            u32x2 w1; w1.x = cvtpk(o1[4 * a], o1[4 * a + 1]); w1.y = cvtpk(o1[4 * a + 2], o1[4 * a + 3]); *(u32x2*)(op + 32 + 8 * a) = w1;
        }
        if (!hn) break;
    }
#undef SB_UNIT_SETUP
}

__device__ __forceinline__ void ld8(const bf16_t* p, float (&v)[8]) {
    const u32x4 w = *(const u32x4*)p;
    v[0] = bf_lo(w.x); v[1] = bf_hi(w.x); v[2] = bf_lo(w.y); v[3] = bf_hi(w.y); v[4] = bf_lo(w.z); v[5] = bf_hi(w.z); v[6] = bf_lo(w.w); v[7] = bf_hi(w.w);
}
__device__ __forceinline__ void st8(bf16_t* p, const float (&v)[8]) {
    u32x4 w; w.x = cvtpk(v[0], v[1]); w.y = cvtpk(v[2], v[3]); w.z = cvtpk(v[4], v[5]); w.w = cvtpk(v[6], v[7]); *(u32x4*)p = w;
}
__device__ __forceinline__ void up8(const u32x4 w, float (&v)[8]) {
    v[0] = bf_lo(w.x); v[1] = bf_hi(w.x); v[2] = bf_lo(w.y); v[3] = bf_hi(w.y); v[4] = bf_lo(w.z); v[5] = bf_hi(w.z); v[6] = bf_lo(w.w); v[7] = bf_hi(w.w);
}
__device__ __forceinline__ void convpool_unit(const bf16_t* __restrict__ P, bf16_t* __restrict__ mixed, const float* convw, int uu, int lane) {
    const int c8 = (lane & 31) * 8, t0 = uu * 16 + (lane >> 5) * 8, s0 = t0 & (SEQ - 1);
    {
        float w0[8], w1[8], w2[8], p2[8], p1[8];
        const bf16_t* pc = P + 1280 + c8; const bf16_t* pu = P + 1536 + c8; const bf16_t* pb = P + 1024 + c8;
        {
            const bool hv = (s0 >= 2);
            const size_t tm2 = hv ? (size_t)(t0 - 2) : (size_t)t0, tm1 = hv ? (size_t)(t0 - 1) : (size_t)t0;
            const u32x4 a2 = *(const u32x4*)(pc + tm2 * PW), b2 = *(const u32x4*)(pu + tm2 * PW), a1 = *(const u32x4*)(pc + tm1 * PW), b1 = *(const u32x4*)(pu + tm1 * PW);
            float x[8], y[8];
            up8(a2, x); up8(b2, y);
#pragma unroll
            for (int i = 0; i < 8; ++i) p2[i] = hv ? x[i] * y[i] : 0.f;
            up8(a1, x); up8(b1, y);
#pragma unroll
            for (int i = 0; i < 8; ++i) p1[i] = hv ? x[i] * y[i] : 0.f;
#pragma unroll
            for (int i = 0; i < 8; ++i) { w0[i] = convw[c8 + i]; w1[i] = convw[256 + c8 + i]; w2[i] = convw[512 + c8 + i]; }
        }
#pragma unroll
        for (int ib = 0; ib < 8; ib += 4) {
            u32x4 rb[4], rc[4], ru[4];
#pragma unroll
            for (int k = 0; k < 4; ++k) { const size_t t = (size_t)(t0 + ib + k) * PW; rb[k] = *(const u32x4*)(pb + t); rc[k] = *(const u32x4*)(pc + t); ru[k] = *(const u32x4*)(pu + t); }
#pragma unroll
            for (int k = 0; k < 4; ++k) { float cb[8], cc[8], cu[8], y[8]; up8(rb[k], cb); up8(rc[k], cc); up8(ru[k], cu);
#pragma unroll
                for (int j = 0; j < 8; ++j) { const float cur = cc[j] * cu[j]; y[j] = cb[j] * (w0[j] * p2[j] + w1[j] * p1[j] + w2[j] * cur); p2[j] = p1[j]; p1[j] = cur; }
                st8(mixed + (size_t)(t0 + ib + k) * DM + 512 + c8, y); }
        }
    }
    {
        const int w = 2 << (c8 >> 6);
        const bf16_t* pp = P + 1792 + c8;
        float sum[8];
#pragma unroll
        for (int i = 0; i < 8; ++i) sum[i] = 0.f;
        {
            u32x4 r[16];
#pragma unroll
            for (int j = 1; j <= 16; ++j) { const bool ok = (j <= w) && (s0 - j >= 0); r[j - 1] = ok ? *(const u32x4*)(pp + (size_t)(t0 - (ok ? j : 0)) * PW) : (u32x4){0u, 0u, 0u, 0u}; }
#pragma unroll
            for (int j = 0; j < 16; ++j) { float v[8]; up8(r[j], v);
#pragma unroll
                for (int i = 0; i < 8; ++i) sum[i] += v[i]; }
        }
#pragma unroll
        for (int ib = 0; ib < 8; ib += 4) {
            u32x4 rc[4], ro[4];
#pragma unroll
            for (int k = 0; k < 4; ++k) { const int s = s0 + ib + k; const bool ok = (s - w >= 0);
                rc[k] = *(const u32x4*)(pp + (size_t)(t0 + ib + k) * PW);
                ro[k] = ok ? *(const u32x4*)(pp + (size_t)(t0 + ib + k - (ok ? w : 0)) * PW) : (u32x4){0u, 0u, 0u, 0u}; }
#pragma unroll
            for (int k = 0; k < 4; ++k) { const int s = s0 + ib + k; float cur[8], old[8], y[8]; up8(rc[k], cur); up8(ro[k], old);
                const float inv = 1.0f / (float)((s + 1 < w) ? (s + 1) : w);
#pragma unroll
                for (int j = 0; j < 8; ++j) { sum[j] += cur[j] - old[j]; y[j] = sum[j] * inv - cur[j]; }
                st8(mixed + (size_t)(t0 + ib + k) * DM + 768 + c8, y); }
        }
    }
}

constexpr int LDS_BYTES = 8 * SB_WAVE_LDS + 256;
constexpr int N_STEPS = 2 + NL * 7;

__global__ void __launch_bounds__(512, 2) fwd_kernel(Args a) {
    extern __shared__ __attribute__((aligned(16))) unsigned char lds_raw[];
    cg::grid_group grid = cg::this_grid();
    LAS unsigned char* lds = (LAS unsigned char*)lds_raw;
    const int G = gridDim.x, NGW = G * 8;
    const int wave0 = __builtin_amdgcn_readfirstlane((int)threadIdx.x >> 6);
#define LANE_VARS int tid = wave0 * 64 + (int)__builtin_amdgcn_mbcnt_hi(~0u, __builtin_amdgcn_mbcnt_lo(~0u, 0u)); asm volatile("" : "+v"(tid)); const int lane = tid & 63, wave = wave0, gw = blockIdx.x * 8 + wave; (void)lane; (void)gw
    unsigned char* ws = a.ws;
    const float* mod = (const float*)(ws + WS_MOD);
    const bf16_t* Wgu = (const bf16_t*)(ws + WS_WGU); const bf16_t* Wd = (const bf16_t*)(ws + WS_WD); const bf16_t* Win = (const bf16_t*)(ws + WS_WIN);
    const bf16_t* Wv = (const bf16_t*)(ws + WS_WV); const bf16_t* Wout = (const bf16_t*)(ws + WS_WOUT);
    float* STATS = (float*)(ws + WS_STATS); float* SWB = (float*)(ws + WS_SW); bf16_t* MIX = (bf16_t*)(ws + WS_MIX); bf16_t* XB = (bf16_t*)(ws + WS_XB); LAS float* scr = (LAS float*)(lds + pg8::STAGE_BYTES);
    bf16_t* H = (bf16_t*)(ws + WS_H); bf16_t* ACT = (bf16_t*)(ws + WS_ACT); bf16_t* PROJ = (bf16_t*)(ws + WS_PROJ); bf16_t* VT = (bf16_t*)(ws + WS_VT);
    const int lo = a.lo, hi = a.hi;
    int step = 0;
#define STEP_ON (step >= lo && step < hi)
    volatile LAS unsigned* bst = (volatile LAS unsigned*)(lds + 8 * SB_WAVE_LDS);
    if (threadIdx.x == 0) { bst[0] = 0u; bst[1] = 0u; }
    unsigned* barw = (unsigned*)(ws + WS_CTL);
    if (blockIdx.x == 0 && lo == 0) for (int i = threadIdx.x; i < XCD_BAR_WORDS; i += 512) __hip_atomic_store(barw + i, 0u, __ATOMIC_RELAXED, __HIP_MEMORY_SCOPE_AGENT);
    __syncthreads();
    XcdBarrier xb; xb.bar = barw; xb.x = 0; xb.st = bst;
#define STEP_END do { ++step; if (step > lo && step < hi) { if (step == 1) { grid.sync(); xb = xcd_barrier_post(barw, bst, wave0); } else xcd_barrier(xb, wave0); } } while (0)

    if (STEP_ON) { LANE_VARS; for (int rep = 0; rep < REP_PRO; ++rep) { prologue(a, lds, tid, lane, wave, gw, NGW); __syncthreads(); } }
    STEP_END;
    if (STEP_ON) { LANE_VARS;
        for (int l = 0; l < NL; ++l) {
            const float* modl = mod + (size_t)l * 8 * NMOD; float* sWl = SWB + (size_t)l * 8 * SW_ROWS;
            sw_rows(Wgu + (size_t)(l * 2) * 5632 * 1024, 5632, modl, sWl + SW_GU1, gw, NGW, lane);
            sw_rows(Win + (size_t)l * 2048 * 1024, 2048, modl + 3072, sWl + SW_IN, gw, NGW, lane);
            sw_rows(Wv + (size_t)l * 512 * 1024, 512, modl + 3072, sWl + SW_V, gw, NGW, lane);
            sw_rows(Wgu + (size_t)(l * 2 + 1) * 5632 * 1024, 5632, modl + 6144, sWl + SW_GU2, gw, NGW, lane);
        }
        init_xt(a.in[0], H, XB, STATS, a.in[4], mod + 1024, gw, NGW, lane);
    }
    STEP_END;

    for (int l = 0; l < NL; ++l) {
        const float* modl = mod + (size_t)l * 8 * NMOD; const float* sWl = SWB + (size_t)l * 8 * SW_ROWS;
        for (int s = 0; s < 3; ++s) {
            if (s != 1) {
                const int f = (s == 0) ? 0 : 1;
                if (STEP_ON) { LANE_VARS;
#define GU_BLOCK { pg8::Gemm g{H, Wgu + (size_t)(l * 2 + f) * 5632 * 1024, MTOK, 5632, DM}; pg8::StaticOrderC<MTOK / 256, 22> S; S.init(MTOK, 5632, G, (int)blockIdx.x); \
                    pg8::EpiSwiGLU E{ACT, STATS, sWl + (f ? SW_GU2 : SW_GU1), scr}; pg8::gemm_phase(lds, g, S, E, tid); }
                    for (int rep = 0; rep < REP_GU; ++rep) GU_BLOCK
                }
                STEP_END;
            } else {
                if (STEP_ON) { LANE_VARS; {
                    { pg8::Gemm g{H, Win + (size_t)l * 2048 * 1024, MTOK, 2048, DM}; pg8::StaticOrderC<MTOK / 256, 8> S; S.init(MTOK, 2048, G, (int)blockIdx.x);
                      pg8::EpiIn E{PROJ, a.in[10] + l * 64, a.in[11] + l * 64, STATS, sWl + SW_IN, scr};
                      pg8::gemm_phase(lds, g, S, E, tid); }
                    { pg8::Gemm g{Wv + (size_t)l * 512 * 1024, H, 512, MTOK, DM}; pg8::StaticOrderC<2, MTOK / 256> S; S.init(512, MTOK, G, (int)blockIdx.x);
                      pg8::EpiVt E{VT, STATS, sWl + SW_V, scr};
                      pg8::gemm_phase(lds, g, S, E, tid); }
                } }
                STEP_END;
                if (STEP_ON) { LANE_VARS; for (int rep = 0; rep < REP_MIX; ++rep) {
                    sb_attn_wave(PROJ, VT, MIX, gw, NGW, lane, lds + wave * SB_WAVE_LDS);
                    for (int u = gw; u < MTOK / 16; u += NGW) convpool_unit(PROJ, MIX, a.in[12] + (size_t)l * 768, u, lane);
                } }
                STEP_END;
            }
            if (STEP_ON) { LANE_VARS;
                const bf16_t* gA = (s != 1) ? (const bf16_t*)ACT : (const bf16_t*)MIX;
                const bf16_t* gB = (s != 1) ? Wd + (size_t)(l * 2 + (s == 0 ? 0 : 1)) * 1024 * FF : Wout + (size_t)l * 1024 * 1024;
                const int gK = (s != 1) ? FF : DM;
                const pg8::Gemm g{gA, gB, MTOK, DM, gK};
                pg8::StaticOrderC<MTOK / 256, 4> S; S.init(MTOK, DM, G, (int)blockIdx.x);
                const bool has_next = !(l == NL - 1 && s == 2);
                const int ln = (s == 2) ? l + 1 : l, sn = (s == 2) ? 0 : s + 1;
                const float* gain_n = (sn == 0 ? a.in[4] : sn == 1 ? a.in[8] : a.in[16]) + (size_t)(has_next ? ln : 0) * DM;
                const float* scale_n = mod + (size_t)(has_next ? ln : 0) * 8 * NMOD + sn * 3072 + 1024;
                bf16_t* xt = has_next ? H : (bf16_t*)nullptr;
                const float* gatep = modl + s * 3072 + 2048;
                const float coef = (s == 1) ? 1.0f : 0.5f;
                const pg8::EpiRes E{XB, XB, a.out, gatep, xt, gain_n, scale_n, STATS, scr, coef};
                pg8::gemm_phase(lds, g, S, E, tid);
            }
            STEP_END;
        }
    }
#undef STEP_ON
#undef STEP_END
}

extern "C" void kernel_launch(void* const* d_in, const int* in_sizes, int n_in, void* d_out, int out_size, void* d_ws, size_t ws_size, hipStream_t stream) {
    static int grid = 0;
    if (grid == 0) {
        if (n_in != 20 || out_size != MTOK * DM || ws_size < WS_END) { fprintf(stderr, "kernel_launch: unexpected problem (n_in %d, out %d, ws %zu)\n", n_in, out_size, ws_size); grid = -1; return; }
        int dev = 0, cus = 0, per_cu = 0;
        (void)hipGetDevice(&dev); (void)hipDeviceGetAttribute(&cus, hipDeviceAttributeMultiprocessorCount, dev);
        if (hipFuncSetAttribute((const void*)fwd_kernel, hipFuncAttributeMaxDynamicSharedMemorySize, LDS_BYTES) != hipSuccess) fprintf(stderr, "kernel_launch: hipFuncSetAttribute failed\n");
        if (hipOccupancyMaxActiveBlocksPerMultiprocessor(&per_cu, (const void*)fwd_kernel, 512, LDS_BYTES) != hipSuccess || per_cu < 1) { fprintf(stderr, "kernel_launch: occupancy query gave %d\n", per_cu); per_cu = 1; }
        (void)hipGetLastError();
        grid = cus * per_cu;
        fprintf(stderr, "kernel_launch: grid %d (cus %d x %d)\n", grid, cus, per_cu);
    }
    if (grid < 0) return;
    Args a{};
    for (int i = 0; i < 20; ++i) a.in[i] = (const float*)d_in[i];
    a.out = (float*)d_out; a.ws = (unsigned char*)d_ws;
#if MK_MULTI_LAUNCH
    for (int st = 0; st < N_STEPS; ++st) { a.lo = st; a.hi = st + 1; hipLaunchKernelGGL(fwd_kernel, dim3(grid), dim3(512), LDS_BYTES, stream, a); }
#else
    a.lo = 0; a.hi = N_STEPS;
    void* args[] = {&a};
    hipError_t e = hipLaunchCooperativeKernel((const void*)fwd_kernel, dim3(grid), dim3(512), args, LDS_BYTES, stream);
    if (e != hipSuccess) fprintf(stderr, "kernel_launch: cooperative launch failed: %s (grid %d)\n", hipGetErrorString(e), grid);
#endif
}
```

```cpp
#include <hip/hip_runtime.h>
#include <hip/hip_cooperative_groups.h>
#include <cstdio>
#include <cstdint>
namespace cg = cooperative_groups;

#ifndef REP_GU
#define REP_GU 1
#endif
#ifndef REP_MIX
#define REP_MIX 1
#endif
#ifndef REP_PRO
#define REP_PRO 1
#endif
#ifndef REP_IN
#define REP_IN 1
#endif
#ifndef REP_RES
#define REP_RES 1
#endif
#ifndef MK_MULTI_LAUNCH
#define MK_MULTI_LAUNCH 0
#endif

#define LAS __attribute__((address_space(3)))
typedef unsigned short bf16_t;
typedef short bf16x8 __attribute__((ext_vector_type(8)));
typedef float f32x4 __attribute__((ext_vector_type(4)));
typedef float f32x16 __attribute__((ext_vector_type(16)));
typedef unsigned u32x4 __attribute__((ext_vector_type(4)));
typedef unsigned u32x2 __attribute__((ext_vector_type(2)));
typedef float f32x2_t __attribute__((ext_vector_type(2)));
typedef __bf16 bf16x2_t __attribute__((ext_vector_type(2)));

constexpr int NL = 4, NBATCH = 8, SEQ = 4096, DM = 1024, FF = 2816, MTOK = NBATCH * SEQ;
constexpr int PW = 2048;
constexpr int NMOD = 9 * DM;
constexpr float EPS = 1e-6f;
constexpr float LOG2E = 1.4426950408889634f;
constexpr float QSCALE = 0.125f * LOG2E;

constexpr size_t MiB = 1u << 20;
constexpr size_t WS_MOD = 0;
constexpr size_t WS_CTL = 1536 * 1024;
constexpr size_t WS_WGU = 2 * MiB;
constexpr size_t WS_WD = 90 * MiB;
constexpr size_t WS_WIN = 134 * MiB;
constexpr size_t WS_WV = 150 * MiB;
constexpr size_t WS_WOUT = 154 * MiB;
constexpr size_t WS_H = 162 * MiB;
constexpr size_t WS_ACT = 226 * MiB;
constexpr size_t WS_PROJ = 226 * MiB;
constexpr size_t WS_VT = 354 * MiB;
constexpr size_t WS_STATS = 402 * MiB;
constexpr size_t WS_SW = 403 * MiB;
constexpr size_t WS_MIX = 406 * MiB;
constexpr size_t WS_XB = 470 * MiB;
constexpr size_t WS_END = 534 * MiB;
constexpr int SW_ROWS = 5632 + 2048 + 512 + 5632, SW_GU1 = 0, SW_IN = 5632, SW_V = 7680, SW_GU2 = 8192;

__device__ __forceinline__ unsigned cvtpk(float lo, float hi) { f32x2_t v = {lo, hi}; bf16x2_t b = __builtin_convertvector(v, bf16x2_t); return __builtin_bit_cast(unsigned, b); }
typedef _Float16 f16x2_t __attribute__((ext_vector_type(2)));
__device__ __forceinline__ unsigned cvtpk_h(float lo, float hi) { f32x2_t v = {lo, hi}; f16x2_t h = __builtin_convertvector(v, f16x2_t); return __builtin_bit_cast(unsigned, h); }
__device__ __forceinline__ f32x2_t unpk_h(unsigned w) { return __builtin_convertvector(__builtin_bit_cast(f16x2_t, w), f32x2_t); }
__device__ __forceinline__ float bf_lo(unsigned w) { return __builtin_bit_cast(float, w << 16); }
__device__ __forceinline__ float bf_hi(unsigned w) { return __builtin_bit_cast(float, w & 0xffff0000u); }

namespace pg8 {
constexpr int BM = 256, BK = 64, HALF = 128, HTB = HALF * BK * 2, STAGE_BYTES = 8 * HTB, NXCD = 8, WGM = 8;
__host__ __device__ __forceinline__ int lds_byte(int r, int c) { const int st = (r >> 4) * 2 + (c >> 5), rr = r & 15, cc = c & 31, ob = rr * 64 + cc * 2; return st * 1024 + (ob ^ (((ob >> 9) & 1) << 5)); }
__host__ __device__ __forceinline__ void stage_rc(int b, int& R, int& C) { const int st = b / 1024, sb = b % 1024, swz = sb ^ (((sb >> 9) & 1) << 5); R = (st >> 1) * 16 + swz / 64; C = (st & 1) * 32 + (swz % 64) / 2; }
__host__ __device__ __forceinline__ int perm32(int rho) { const int n = rho >> 4, i = rho & 15; return 8 * (i >> 2) + 4 * n + (i & 3); }

struct Unit { int pm, pn; };
struct Gemm { const bf16_t* A; const bf16_t* Bt; int M, N, K; };

struct StaticOrder {
    int nM, nN, nwg, G, c;
    __device__ void init(int M, int N, int G_, int c_) { nM = M / BM; nN = N / BM; nwg = nM * nN; G = G_; c = c_; }
    __device__ bool next(int i, Unit& u) const {
        const long L = (long)i * G + c; if (L >= nwg) return false;
        int wgid = (int)L; { const int q = nwg / NXCD, r = nwg % NXCD, xcd = wgid % NXCD, off = wgid / NXCD; wgid = (xcd < r ? xcd * (q + 1) : r * (q + 1) + (xcd - r) * q) + off; }
        const int nig = WGM * nN, gid = wgid / nig, fm = gid * WGM, gsz = (nM - fm) < WGM ? (nM - fm) : WGM;
        u.pm = fm + ((wgid % nig) % gsz); u.pn = (wgid % nig) / gsz; return true;
    }
};

template <int NMc, int NNc> struct StaticOrderC {
    int G, c;
    __device__ void init(int, int, int G_, int c_) { G = G_; c = c_; }
    __device__ bool next(int i, Unit& u) const {
        constexpr int nwg = NMc * NNc, q = nwg / NXCD, r = nwg % NXCD, nig = WGM * NNc;
        const long L = (long)i * G + c; if (L >= nwg) return false;
        int wgid = (int)L; { const int xcd = wgid % NXCD, off = wgid / NXCD; wgid = (xcd < r ? xcd * (q + 1) : r * (q + 1) + (xcd - r) * q) + off; }
        const int gid = wgid / nig, fm = gid * WGM, gsz = (NMc % WGM == 0) ? WGM : ((NMc - fm) < WGM ? (NMc - fm) : WGM);
        u.pm = fm + ((wgid % nig) % gsz); u.pn = (wgid % nig) / gsz; return true;
    }
};


struct PreNorm { f32x4 st; float sw; };
__device__ __forceinline__ PreNorm prenorm_load(const float* stats, int row0, const float* swp, int tid) {
    PreNorm p; p.st = (f32x4){0.f, 0.f, 0.f, 0.f}; p.sw = 0.f;
    if (tid < 256) { p.st = *(const f32x4*)(stats + (size_t)(row0 + tid) * 4); p.sw = swp[tid]; }
    return p;
}
__device__ __forceinline__ void prenorm_commit(const PreNorm& p, LAS float* scr, int tid) {
    if (tid < 256) { scr[tid] = rsqrtf(((p.st[0] + p.st[1]) + (p.st[2] + p.st[3])) * (1.0f / DM) + EPS); scr[256 + tid] = p.sw; }
    asm volatile("s_waitcnt lgkmcnt(0)" ::: "memory"); __builtin_amdgcn_s_barrier(); asm volatile("" ::: "memory");
}

struct EpiVt {
    static constexpr bool PERM = true;
    bf16_t* O; const float* stats; const float* sW; LAS float* scr;
    typedef PreNorm Pre;
    __device__ __forceinline__ Pre prefetch(const Unit& u, int tid) const { return prenorm_load(stats, u.pn * BM, sW + (size_t)(u.pn >> 4) * SW_ROWS + u.pm * BM, tid); }
    __device__ __forceinline__ void operator()(const f32x4 (&acc)[2][2][4][2], const Unit& u, int wr, int wc, int fr, int fq, int tid, const Pre& pre) const {
        prenorm_commit(pre, scr, tid);
        const int row0 = u.pm * BM + wr * 64 + fr; const int col0 = u.pn * BM + wc * 32 + 8 * fq;
        f32x4 rs[2][2];
#pragma unroll
        for (int bj = 0; bj < 2; ++bj)
#pragma unroll
            for (int n = 0; n < 2; ++n) rs[bj][n] = *(const LAS f32x4*)(scr + bj * HALF + wc * 32 + 8 * fq + 4 * n);
#pragma unroll
        for (int ai = 0; ai < 2; ++ai)
#pragma unroll
            for (int m = 0; m < 4; ++m) { const int row = row0 + ai * HALF + m * 16; bf16_t* rowp = O + (size_t)row * MTOK + col0;
                const float sh = scr[256 + ai * HALF + wr * 64 + m * 16 + fr];
#pragma unroll
                for (int bj = 0; bj < 2; ++bj) { const f32x4 v0 = acc[ai][bj][m][0] * rs[bj][0] + sh, v1 = acc[ai][bj][m][1] * rs[bj][1] + sh;
                    u32x4 w; w.x = cvtpk(v0[0], v0[1]); w.y = cvtpk(v0[2], v0[3]); w.z = cvtpk(v1[0], v1[1]); w.w = cvtpk(v1[2], v1[3]);
                    *(u32x4*)(rowp + bj * HALF) = w; } }
    }
};

__device__ __forceinline__ float silu2(float g2, float u2) { return (g2 * u2) * __builtin_amdgcn_rcpf(1.0f + __builtin_amdgcn_exp2f(g2)); }
__device__ __forceinline__ float silu_mul(float g, float u) { return g * __builtin_amdgcn_rcpf(1.0f + __builtin_amdgcn_exp2f(-g * LOG2E)) * u; }
struct EpiSwiGLU {
    static constexpr bool PERM = true;
    bf16_t* O; const float* stats; const float* sW; LAS float* scr;
    typedef PreNorm Pre;
    __device__ __forceinline__ Pre prefetch(const Unit& u, int tid) const { return prenorm_load(stats, u.pm * BM, sW + (size_t)(u.pm >> 4) * SW_ROWS + u.pn * BM, tid); }
    __device__ __forceinline__ void operator()(const f32x4 (&acc)[2][2][4][2], const Unit& u, int wr, int wc, int fr, int fq, int tid, const Pre& pre) const {
        prenorm_commit(pre, scr, tid);
        const int row0 = u.pm * BM + wr * 64 + fr; const int col0 = u.pn * HALF + wc * 32 + 8 * fq;
        const LAS float* sp = scr + 256 + wc * 32 + 8 * fq;
        const f32x4 sg0 = *(const LAS f32x4*)sp * (-LOG2E), sg1 = *(const LAS f32x4*)(sp + 4) * (-LOG2E), su0 = *(const LAS f32x4*)(sp + HALF) * (-1.0f / LOG2E), su1 = *(const LAS f32x4*)(sp + HALF + 4) * (-1.0f / LOG2E);
#pragma unroll
        for (int ai = 0; ai < 2; ++ai)
#pragma unroll
            for (int m = 0; m < 4; ++m) { bf16_t* rowp = O + (size_t)(row0 + ai * HALF + m * 16) * FF + col0;
                const float rs = scr[ai * HALF + wr * 64 + m * 16 + fr]; const float rsg = rs * (-LOG2E), rsu = rs * (-1.0f / LOG2E);
                const f32x4 g0 = acc[ai][0][m][0] * rsg + sg0, g1 = acc[ai][0][m][1] * rsg + sg1, u0 = acc[ai][1][m][0] * rsu + su0, u1 = acc[ai][1][m][1] * rsu + su1;
                u32x4 w; w.x = cvtpk(silu2(g0[0], u0[0]), silu2(g0[1], u0[1])); w.y = cvtpk(silu2(g0[2], u0[2]), silu2(g0[3], u0[3]));
                w.z = cvtpk(silu2(g1[0], u1[0]), silu2(g1[1], u1[1])); w.w = cvtpk(silu2(g1[2], u1[2]), silu2(g1[3], u1[3]));
                *(u32x4*)rowp = w; }
    }
};

struct EpiRes {
    static constexpr bool PERM = true;
    const bf16_t* base; bf16_t* xb; float* out; const float* gate;
    bf16_t* XT; const float* gain_n; const float* scale_n; float* stats; LAS float* scr; float coef;
    struct Pre { float gv, gsn; };
    __device__ __forceinline__ Pre prefetch(const Unit& u, int tid) const {
        Pre p; p.gv = 0.f; p.gsn = 0.f;
        if (tid < 256) { const int b = u.pm >> 4, col = u.pn * BM + tid;
            p.gv = (gate[(size_t)b * NMOD + col] + 1.0f) * coef;
            if (XT != nullptr) p.gsn = gain_n[col] * (scale_n[(size_t)b * NMOD + col] + 1.0f); }
        return p;
    }
    __device__ __forceinline__ void operator()(const f32x4 (&acc)[2][2][4][2], const Unit& u, int wr, int wc, int fr, int fq, int tid, const Pre& pre) const {
        const int row0 = u.pm * BM + wr * 64 + fr; const int col0 = u.pn * BM + wc * 32 + 8 * fq;
        const bool nx = (XT != nullptr);
        u32x4 bw[4][2][2];
#define RES_LOAD(q) do { _Pragma("unroll") for (int mm = 0; mm < 2; ++mm) _Pragma("unroll") for (int bj = 0; bj < 2; ++bj) \
            bw[q][mm][bj] = __builtin_nontemporal_load((const u32x4*)(base + (size_t)(row0 + ((q) >> 1) * HALF + (((q) & 1) * 2 + mm) * 16) * DM + col0 + bj * HALF)); asm volatile("" ::: "memory"); } while (0)
        RES_LOAD(0);
        LAS float* tb = scr + 1024;
        if (tid < 256) { tb[tid] = pre.gv; tb[256 + tid] = pre.gsn; }
        asm volatile("s_waitcnt lgkmcnt(0)" ::: "memory"); __builtin_amdgcn_s_barrier(); asm volatile("" ::: "memory");
        f32x4 gv[2][2], gsn[2][2];
#pragma unroll
        for (int bj = 0; bj < 2; ++bj)
#pragma unroll
            for (int n = 0; n < 2; ++n) { gv[bj][n] = *(const LAS f32x4*)(tb + bj * HALF + wc * 32 + 8 * fq + 4 * n); gsn[bj][n] = *(const LAS f32x4*)(tb + 256 + bj * HALF + wc * 32 + 8 * fq + 4 * n); }
        RES_LOAD(1);
#pragma unroll
        for (int q = 0; q < 4; ++q) {
            const int ai = q >> 1;
#pragma unroll
            for (int mm = 0; mm < 2; ++mm) { const int m = (q & 1) * 2 + mm; const size_t off = (size_t)(row0 + ai * HALF + m * 16) * DM + col0; float ss = 0.f;
#pragma unroll
                for (int bj = 0; bj < 2; ++bj) {
                    const f32x2_t h0 = unpk_h(bw[q][mm][bj].x), h1 = unpk_h(bw[q][mm][bj].y), h2 = unpk_h(bw[q][mm][bj].z), h3 = unpk_h(bw[q][mm][bj].w);
                    const f32x4 b0 = {h0[0], h0[1], h1[0], h1[1]}, b1 = {h2[0], h2[1], h3[0], h3[1]};
                    const f32x4 o0 = b0 + gv[bj][0] * acc[ai][bj][m][0], o1 = b1 + gv[bj][1] * acc[ai][bj][m][1];
                    if (nx) { ss += ((o0[0] * o0[0] + o0[1] * o0[1]) + (o0[2] * o0[2] + o0[3] * o0[3])) + ((o1[0] * o1[0] + o1[1] * o1[1]) + (o1[2] * o1[2] + o1[3] * o1[3]));
                        u32x4 xw; xw.x = cvtpk_h(o0[0], o0[1]); xw.y = cvtpk_h(o0[2], o0[3]); xw.z = cvtpk_h(o1[0], o1[1]); xw.w = cvtpk_h(o1[2], o1[3]);
                        __builtin_nontemporal_store(xw, (u32x4*)(xb + off + bj * HALF));
                        const f32x4 t0 = o0 * gsn[bj][0], t1 = o1 * gsn[bj][1];
                        u32x4 w; w.x = cvtpk(t0[0], t0[1]); w.y = cvtpk(t0[2], t0[3]); w.z = cvtpk(t1[0], t1[1]); w.w = cvtpk(t1[2], t1[3]);
                        *(u32x4*)(XT + off + bj * HALF) = w; }
                    else { *(f32x4*)(out + off + bj * HALF) = o0; *(f32x4*)(out + off + bj * HALF + 4) = o1; } }
                if (nx) { ss += __shfl_xor(ss, 16); ss += __shfl_xor(ss, 32); if (fq == 0) scr[(ai * HALF + wr * 64 + m * 16 + fr) * 4 + wc] = ss; } }
            if (q == 0) RES_LOAD(2); else if (q == 1) RES_LOAD(3); else asm volatile("" ::: "memory");
        }
#undef RES_LOAD
        if (nx) {
            asm volatile("s_waitcnt lgkmcnt(0)" ::: "memory"); __builtin_amdgcn_s_barrier(); asm volatile("" ::: "memory");
            if (tid < 256) { const f32x4 p = *(const LAS f32x4*)(scr + tid * 4); stats[(size_t)(u.pm * BM + tid) * 4 + u.pn] = (p[0] + p[1]) + (p[2] + p[3]); }
        }
    }
};

struct EpiIn {
    static constexpr bool PERM = true;
    bf16_t* O; const float* qg; const float* kg; const float* stats; const float* sW; LAS float* scr;
    typedef PreNorm Pre;
    __device__ __forceinline__ Pre prefetch(const Unit& u, int tid) const { return prenorm_load(stats, u.pm * BM, sW + (size_t)(u.pm >> 4) * SW_ROWS + u.pn * BM, tid); }
    __device__ __forceinline__ void operator()(f32x4 (&acc)[2][2][4][2], const Unit& u, int wr, int wc, int fr, int fq, int tid, const Pre& pre) const {
        prenorm_commit(pre, scr, tid);
        const int row0 = u.pm * BM + wr * 64 + fr;
        f32x4 sv[2][2];
#pragma unroll
        for (int bj = 0; bj < 2; ++bj)
#pragma unroll
            for (int n = 0; n < 2; ++n) sv[bj][n] = *(const LAS f32x4*)(scr + 256 + bj * HALF + wc * 32 + 8 * fq + 4 * n);
        if (u.pn < 4) {
            const float* gn = (u.pn < 2) ? qg : kg; const float sc = (u.pn < 2) ? QSCALE : 1.0f;
            f32x4 gv[2][2];
#pragma unroll
            for (int bj = 0; bj < 2; ++bj)
#pragma unroll
                for (int n = 0; n < 2; ++n) gv[bj][n] = *(const f32x4*)(gn + 32 * bj + 8 * fq + 4 * n) * sc;
            const int col0 = u.pn * BM + wc * 64 + 8 * fq;
#pragma unroll
            for (int ai = 0; ai < 2; ++ai)
#pragma unroll
                for (int m = 0; m < 4; ++m) {
                    const float rsn = scr[ai * HALF + wr * 64 + m * 16 + fr];
                    f32x4 x[2][2]; float ss = 0.f;
#pragma unroll
                    for (int bj = 0; bj < 2; ++bj)
#pragma unroll
                        for (int n = 0; n < 2; ++n) { x[bj][n] = acc[ai][bj][m][n] * rsn + sv[bj][n]; ss += (x[bj][n][0] * x[bj][n][0] + x[bj][n][1] * x[bj][n][1]) + (x[bj][n][2] * x[bj][n][2] + x[bj][n][3] * x[bj][n][3]); }
                    ss += __shfl_xor(ss, 16); ss += __shfl_xor(ss, 32);
                    const float rs = rsqrtf(ss * (1.0f / 64.0f) + EPS);
                    bf16_t* rowp = O + (size_t)(row0 + ai * HALF + m * 16) * PW + col0;
#pragma unroll
                    for (int bj = 0; bj < 2; ++bj) { const f32x4 v0 = x[bj][0] * rs * gv[bj][0], v1 = x[bj][1] * rs * gv[bj][1];
                        u32x4 w; w.x = cvtpk(v0[0], v0[1]); w.y = cvtpk(v0[2], v0[3]); w.z = cvtpk(v1[0], v1[1]); w.w = cvtpk(v1[2], v1[3]);
                        *(u32x4*)(rowp + 32 * bj) = w; }
                }
        } else {
            const int col0 = u.pn * BM + wc * 32 + 8 * fq;
#pragma unroll
            for (int ai = 0; ai < 2; ++ai)
#pragma unroll
                for (int m = 0; m < 4; ++m) { bf16_t* rowp = O + (size_t)(row0 + ai * HALF + m * 16) * PW + col0;
                    const float rsn = scr[ai * HALF + wr * 64 + m * 16 + fr];
#pragma unroll
                    for (int bj = 0; bj < 2; ++bj) { const f32x4 v0 = acc[ai][bj][m][0] * rsn + sv[bj][0], v1 = acc[ai][bj][m][1] * rsn + sv[bj][1];
                        u32x4 w; w.x = cvtpk(v0[0], v0[1]); w.y = cvtpk(v0[2], v0[3]); w.z = cvtpk(v1[0], v1[1]); w.w = cvtpk(v1[2], v1[3]);
                        *(u32x4*)(rowp + bj * HALF) = w; } }
        }
    }
};

template <class Epi, class Sched>
__device__ __forceinline__ void gemm_phase(LAS unsigned char* lds, const Gemm g, const Sched& S, const Epi& E, const int tid) {
    const int wid = __builtin_amdgcn_readfirstlane(tid >> 6), lane = tid & 63, wr = wid >> 2, wc = wid & 3, fr = lane & 15, fq = lane >> 4;
    const int K = g.K, nt = K / BK;
    unsigned voffA[2], voffB[2];
#pragma unroll
    for (int i = 0; i < 2; ++i) { int R, C; stage_rc(tid * 16 + i * 8192, R, C); const int Rb = Epi::PERM ? ((R & ~31) + perm32(R & 31)) : R;
        voffA[i] = (unsigned)(R * K + C) * 2u; voffB[i] = (unsigned)(Rb * K + C) * 2u; }
    const size_t kstep = (size_t)(BK * 2);
    const size_t hstep = (size_t)HALF * K * 2;
    const size_t tstep = 2 * hstep;
    const unsigned ldsw = (unsigned)wid * 1024u;
    const int aoff = lds_byte(wr * 64 + fr, fq * 8), boff = lds_byte(wc * 32 + fr, fq * 8);
#define PG8_SA(b, h) (((b) * 2 + (h)) * HTB)
#define PG8_SB(b, h) ((4 + (b) * 2 + (h)) * HTB)
#define PG8_STAGE(bufoff, gbase, voff) do { _Pragma("unroll") for (int _i = 0; _i < 2; ++_i) \
        __builtin_amdgcn_global_load_lds((const unsigned*)((const char*)(gbase) + (voff)[_i]), (LAS unsigned*)(lds + (bufoff) + ldsw + _i * 8192), 16, 0, 0); } while (0)
#define PG8_LDA(dst, b, h) do { _Pragma("unroll") for (int m = 0; m < 4; ++m) _Pragma("unroll") for (int k = 0; k < 2; ++k) dst[m][k] = *(const LAS bf16x8*)(lds + PG8_SA(b, h) + aoff + m * 2048 + k * 1024); } while (0)
#define PG8_LDB(dst, b, h) do { _Pragma("unroll") for (int n = 0; n < 2; ++n) _Pragma("unroll") for (int k = 0; k < 2; ++k) dst[n][k] = *(const LAS bf16x8*)(lds + PG8_SB(b, h) + boff + n * 2048 + k * 1024); } while (0)
#define PG8_MMA(ai, bj, At, Bt) do { __builtin_amdgcn_s_setprio(1); _Pragma("unroll") for (int m = 0; m < 4; ++m) _Pragma("unroll") for (int n = 0; n < 2; ++n) _Pragma("unroll") for (int k = 0; k < 2; ++k) \
        acc[ai][bj][m][n] = __builtin_amdgcn_mfma_f32_16x16x32_bf16(Bt[n][k], At[m][k], acc[ai][bj][m][n], 0, 0, 0); __builtin_amdgcn_s_setprio(0); } while (0)
#define PG8_WAIT_V(n) asm volatile("s_waitcnt vmcnt(" #n ")" ::: "memory")
#define PG8_WAIT_L(n) asm volatile("s_waitcnt lgkmcnt(" #n ")" ::: "memory")
#define PG8_BAR __builtin_amdgcn_s_barrier()
#define PG8_SCHED __builtin_amdgcn_sched_barrier(0)
    Unit cur, nxt; int ui = 0;
    if (!S.next(0, cur)) return;
    f32x4 acc[2][2][4][2];
#pragma unroll
    for (int a = 0; a < 2; ++a)
#pragma unroll
        for (int b = 0; b < 2; ++b)
#pragma unroll
            for (int m = 0; m < 4; ++m)
#pragma unroll
                for (int n = 0; n < 2; ++n) acc[a][b][m][n] = (f32x4){0.f, 0.f, 0.f, 0.f};
    bf16x8 At[4][2], B0[2][2], B1[2][2];
    const char* cA = (const char*)g.A + (size_t)cur.pm * tstep; const char* cB = (const char*)g.Bt + (size_t)cur.pn * tstep;
    PG8_STAGE(PG8_SB(0, 0), cB, voffB); PG8_STAGE(PG8_SB(0, 1), cB + hstep, voffB); PG8_STAGE(PG8_SA(0, 0), cA, voffA); PG8_STAGE(PG8_SA(0, 1), cA + hstep, voffA);
    if (wr == 1) PG8_BAR;
    PG8_WAIT_V(2); PG8_BAR;
    PG8_STAGE(PG8_SB(1, 0), cB + kstep, voffB); PG8_STAGE(PG8_SA(1, 0), cA + kstep, voffA); PG8_STAGE(PG8_SB(1, 1), cB + hstep + kstep, voffB);
    PG8_WAIT_V(6); PG8_BAR;
    for (;;) {
        const bool has_next = S.next(ui + 1, nxt);
        const char* nA = has_next ? (const char*)g.A + (size_t)nxt.pm * tstep : cA; const char* nB = has_next ? (const char*)g.Bt + (size_t)nxt.pn * tstep : cB;
        const typename Epi::Pre pre = E.prefetch(cur, tid);
        for (int t = 0; t < nt; t += 2) {
            const bool last = (t == nt - 2);
            const char* a1 = cA + (size_t)(t + 1) * kstep;
            const char* a2 = last ? nA : cA + (size_t)(t + 2) * kstep; const char* b2 = last ? nB : cB + (size_t)(t + 2) * kstep;
            const char* a3 = a2 + kstep; const char* b3 = b2 + kstep;
            PG8_LDB(B0, 0, 0); PG8_LDB(B1, 0, 1); PG8_SCHED; PG8_LDA(At, 0, 0); PG8_STAGE(PG8_SA(1, 1), a1 + hstep, voffA);
            PG8_WAIT_V(8); PG8_WAIT_L(0); PG8_BAR; PG8_MMA(0, 0, At, B0); PG8_MMA(0, 1, At, B1); PG8_BAR; PG8_SCHED;
            PG8_LDA(At, 0, 1); PG8_STAGE(PG8_SB(0, 0), b2, voffB); PG8_STAGE(PG8_SB(0, 1), b2 + hstep, voffB); PG8_STAGE(PG8_SA(0, 0), a2, voffA);
            PG8_WAIT_V(8); PG8_WAIT_L(0); PG8_BAR; PG8_MMA(1, 0, At, B0); PG8_MMA(1, 1, At, B1); PG8_BAR; PG8_SCHED;
            PG8_LDB(B0, 1, 0); PG8_LDB(B1, 1, 1); PG8_SCHED; PG8_LDA(At, 1, 0); PG8_STAGE(PG8_SA(0, 1), a2 + hstep, voffA);
            PG8_WAIT_V(8); PG8_WAIT_L(0); PG8_BAR; PG8_MMA(0, 0, At, B0); PG8_MMA(0, 1, At, B1); PG8_BAR; PG8_SCHED;
            PG8_LDA(At, 1, 1); PG8_STAGE(PG8_SB(1, 0), b3, voffB); PG8_STAGE(PG8_SB(1, 1), b3 + hstep, voffB); PG8_STAGE(PG8_SA(1, 0), a3, voffA);
            PG8_WAIT_V(8); PG8_WAIT_L(0); PG8_BAR; PG8_MMA(1, 0, At, B0); PG8_MMA(1, 1, At, B1); PG8_BAR; PG8_SCHED;
        }
        if (wr == 0) PG8_BAR;
        E(acc, cur, wr, wc, fr, fq, tid, pre);
        if (!has_next) break;
#pragma unroll
        for (int a = 0; a < 2; ++a)
#pragma unroll
            for (int b = 0; b < 2; ++b)
#pragma unroll
                for (int m = 0; m < 4; ++m)
#pragma unroll
                    for (int n = 0; n < 2; ++n) acc[a][b][m][n] = (f32x4){0.f, 0.f, 0.f, 0.f};
        cur = nxt; cA = nA; cB = nB; ++ui;
        if (wr == 1) PG8_BAR;
    }
    PG8_WAIT_V(0);
    PG8_BAR;
#undef PG8_SA
#undef PG8_SB
#undef PG8_STAGE
#undef PG8_LDA
#undef PG8_LDB
#undef PG8_MMA
#undef PG8_WAIT_V
#undef PG8_WAIT_L
#undef PG8_BAR
#undef PG8_SCHED
}
}

#define XB_TMO      128
#define XB_XCNT(j)  (256  + 64 * (j))
#define XB_XSUB(j)  (1280 + 64 * (j))
#define XB_XGEN(j)  (2304 + 64 * (j))
#define XB_TOP      3328
#define XB_TOPGEN   3392
#define XCD_BAR_WORDS 3456
#define XB_SPIN_CAP (1u << 22)
__device__ __forceinline__ unsigned xb_ld(unsigned* p)              { return __hip_atomic_load(p, __ATOMIC_RELAXED, __HIP_MEMORY_SCOPE_AGENT); }
__device__ __forceinline__ unsigned xb_add(unsigned* p, unsigned v) { return __hip_atomic_fetch_add(p, v, __ATOMIC_RELAXED, __HIP_MEMORY_SCOPE_AGENT); }
__device__ __forceinline__ unsigned xb_xcc_id() { return (unsigned)__builtin_amdgcn_s_getreg((3 << 11) | 20) & 0xFu; }
#define XB_SPIN(cond, bar) do { unsigned _sp = 0; while (cond) { __builtin_amdgcn_s_sleep(1); \
    if ((++_sp & 255u) == 0u) { if (xb_ld(&(bar)[XB_TMO])) break; if (_sp > XB_SPIN_CAP) { atomicAdd(&(bar)[XB_TMO], 1u); break; } } } } while (0)
struct XcdBarrier { unsigned* bar; unsigned x; volatile LAS unsigned* st; };
__device__ __forceinline__ bool is_thread0(int wave0) { return wave0 == 0 && __builtin_amdgcn_mbcnt_hi(~0u, __builtin_amdgcn_mbcnt_lo(~0u, 0u)) == 0u; }
__device__ __forceinline__ XcdBarrier xcd_barrier_post(unsigned* bar, volatile LAS unsigned* st, int wave0) {
    XcdBarrier b; b.bar = bar; b.x = xb_xcc_id(); b.st = st;
    if (is_thread0(wave0)) (void)xb_add(&bar[XB_XCNT(b.x)], 1u);
    return b;
}
__device__ __forceinline__ void xcd_barrier_complete(unsigned* bar, unsigned x, unsigned& nloc, unsigned& nx) {
    const unsigned G = gridDim.x * gridDim.y * gridDim.z;
    unsigned sum, cnt, mine, sp = 0u;
    for (;;) {
        sum = 0u; cnt = 0u; mine = 0u;
#pragma unroll
        for (unsigned j = 0; j < 16; ++j) { const unsigned c = xb_ld(&bar[XB_XCNT(j)]); sum += c; cnt += (c > 0u) ? 1u : 0u; mine = (j == x) ? c : mine; }
        if (sum == G) break;
        __builtin_amdgcn_s_sleep(1);
        if ((++sp & 255u) == 0u) { if (xb_ld(&bar[XB_TMO])) break; if (sp > XB_SPIN_CAP) { atomicAdd(&bar[XB_TMO], 1u); break; } }
    }
    nloc = mine > 0u ? mine : 1u; nx = cnt > 0u ? cnt : 1u;
}
__device__ __forceinline__ void xcd_barrier(const XcdBarrier& b, int wave0) {
    asm volatile("s_waitcnt vmcnt(0)" ::: "memory");
    __syncthreads();
    if (is_thread0(wave0)) {
        unsigned* bar = b.bar;
        __builtin_amdgcn_s_waitcnt(0);
        unsigned nloc = b.st[0], nx = b.st[1];
        if (nloc == 0u) { xcd_barrier_complete(bar, b.x, nloc, nx); b.st[0] = nloc; b.st[1] = nx; }
        const unsigned old = xb_add(&bar[XB_XSUB(b.x)], 1u);
        const unsigned gen = old / nloc;
        if (old + 1u == (gen + 1u) * nloc) {
            __builtin_amdgcn_fence(__ATOMIC_RELEASE, "agent");
            asm volatile("s_waitcnt vmcnt(0)" ::: "memory");
            const unsigned og = xb_add(&bar[XB_TOP], 1u);
            const unsigned tg = og / nx;
            if (og + 1u == (tg + 1u) * nx) xb_add(&bar[XB_TOPGEN], 1u);
            else XB_SPIN(xb_ld(&bar[XB_TOPGEN]) == tg, bar);
            __builtin_amdgcn_fence(__ATOMIC_ACQUIRE, "agent");
            xb_add(&bar[XB_XGEN(b.x)], 1u);
            asm volatile("s_waitcnt vmcnt(0)" ::: "memory");
        } else {
            XB_SPIN(xb_ld(&bar[XB_XGEN(b.x)]) == gen, bar);
            __builtin_amdgcn_fence(__ATOMIC_ACQUIRE, "agent");
            asm volatile("s_waitcnt vmcnt(0)" ::: "memory");
        }
    }
    __syncthreads();
}

struct Args { const float* in[20]; float* out; unsigned char* ws; int lo, hi; };

__device__ __forceinline__ float wave_sum(float v) {
#pragma unroll
    for (int o = 1; o < 64; o <<= 1) v += __shfl_xor(v, o);
    return v;
}

__device__ __forceinline__ void transpose_item(const float* W, int ldw, int s0, int k0, bf16_t* WT, int ldt, int j0, LAS float* scr, int lane) {
    const int kr = lane >> 3, c4 = (lane & 7) * 4;
    f32x4 v[8];
#pragma unroll
    for (int i = 0; i < 8; ++i) v[i] = __builtin_nontemporal_load((const f32x4*)(W + (size_t)(k0 + 8 * i + kr) * ldw + s0 + c4));
#pragma unroll
    for (int i = 0; i < 8; ++i) { LAS float* d = scr + (8 * i + kr) * 33 + c4; d[0] = v[i][0]; d[1] = v[i][1]; d[2] = v[i][2]; d[3] = v[i][3]; }
    asm volatile("s_waitcnt lgkmcnt(0)" ::: "memory");
    const int c = lane & 7;
#pragma unroll
    for (int j = 0; j < 4; ++j) { const int n = (lane >> 3) + 8 * j; const LAS float* s = scr + (8 * c) * 33 + n;
        u32x4 o; o.x = cvtpk(s[0 * 33], s[1 * 33]); o.y = cvtpk(s[2 * 33], s[3 * 33]); o.z = cvtpk(s[4 * 33], s[5 * 33]); o.w = cvtpk(s[6 * 33], s[7 * 33]);
        *(u32x4*)(WT + (size_t)(j0 + n) * ldt + k0 + 8 * c) = o; }
    asm volatile("s_waitcnt lgkmcnt(0)" ::: "memory");
}

constexpr int I_GU = 16 * 176, I_D = 44 * 32, I_IN = 16 * 56, I_V = 16 * 16, I_O = 16 * 32, I_LAYER = 2 * I_GU + 2 * I_D + I_IN + I_V + I_O;

__device__ __forceinline__ void prologue(const Args& a, LAS unsigned char* lds, int tid, int lane, int wave, int gw, int NGW) {
    unsigned char* ws = a.ws;
    float* mod = (float*)(ws + WS_MOD);
    bf16_t* Wgu = (bf16_t*)(ws + WS_WGU); bf16_t* Wd = (bf16_t*)(ws + WS_WD); bf16_t* Win = (bf16_t*)(ws + WS_WIN); bf16_t* Wv = (bf16_t*)(ws + WS_WV); bf16_t* Wout = (bf16_t*)(ws + WS_WOUT);
    {
        LAS float* condt = (LAS float*)lds; LAS float* red = condt + 8192;
        const float* c = a.in[1];
        for (int i = tid; i < 8192; i += 512) { const int b = i >> 10, k = i & 1023; const float v = c[i]; condt[k * 8 + b] = v / (1.0f + __expf(-v)); }
        __syncthreads();
        for (int item = blockIdx.x; item < NL * 64; item += gridDim.x) {
            const int l = item >> 6, col0 = (item & 63) * 144;
            f32x4 acc[8];
#pragma unroll
            for (int b = 0; b < 8; ++b) acc[b] = (f32x4){0.f, 0.f, 0.f, 0.f};
            if (lane < 36) {
                const float* wp = a.in[2] + ((size_t)l * 1024 + wave * 128) * NMOD + col0 + 4 * lane;
#pragma unroll 8
                for (int kk = 0; kk < 128; ++kk) { const f32x4 wv = __builtin_nontemporal_load((const f32x4*)(wp + (size_t)kk * NMOD));
                    const f32x4 c0 = *(const LAS f32x4*)(condt + (wave * 128 + kk) * 8), c1 = *(const LAS f32x4*)(condt + (wave * 128 + kk) * 8 + 4);
                    acc[0] += wv * c0[0]; acc[1] += wv * c0[1]; acc[2] += wv * c0[2]; acc[3] += wv * c0[3]; acc[4] += wv * c1[0]; acc[5] += wv * c1[1]; acc[6] += wv * c1[2]; acc[7] += wv * c1[3]; }
#pragma unroll
                for (int b = 0; b < 8; ++b) *(LAS f32x4*)(red + (wave * 8 + b) * 144 + 4 * lane) = acc[b];
            }
            __syncthreads();
            for (int o = tid; o < 8 * 144; o += 512) { const int b = o / 144, n = o % 144; float sm = 0.f;
#pragma unroll
                for (int w = 0; w < 8; ++w) sm += red[(w * 8 + b) * 144 + n];
                mod[((size_t)l * 8 + b) * NMOD + col0 + n] = sm + a.in[3][(size_t)l * NMOD + col0 + n]; }
            __syncthreads();
        }
    }
    {
        LAS float* scr = (LAS float*)(lds + wave * 16384);
        for (int it = gw; it < NL * I_LAYER; it += NGW) {
            const int l = it / I_LAYER; int r = it % I_LAYER;
            const float* W; int ldw, s0, k0, ldt, j0; bf16_t* WT;
            if (r < 2 * I_GU) { const int f = r / I_GU; r %= I_GU; const int kb = r / 176, nb = r % 176; j0 = nb * 32; k0 = kb * 64;
                const float* gate = f ? a.in[17] : a.in[5]; const float* up = f ? a.in[18] : a.in[6];
                W = ((j0 & 128) ? up : gate) + (size_t)l * DM * FF; ldw = FF; s0 = 128 * (j0 >> 8) + (j0 & 127);
                WT = Wgu + (size_t)(l * 2 + f) * 5632 * 1024; ldt = 1024; }
            else if ((r -= 2 * I_GU) < 2 * I_D) { const int f = r / I_D; r %= I_D; const int kb = r / 32, nb = r % 32; j0 = nb * 32; k0 = kb * 64;
                W = (f ? a.in[19] : a.in[7]) + (size_t)l * FF * DM; ldw = DM; s0 = j0; WT = Wd + (size_t)(l * 2 + f) * 1024 * FF; ldt = FF; }
            else if ((r -= 2 * I_D) < I_IN) { const int kb = r / 56, nb = r % 56; j0 = nb * 32; k0 = kb * 64; W = a.in[9] + (size_t)l * DM * 2560; ldw = 2560;
                s0 = (j0 < 1024) ? (256 * (j0 >> 8) + 64 * ((j0 >> 5) & 3) + 32 * ((j0 >> 7) & 1)) : (j0 + 512);
                WT = Win + (size_t)l * 2048 * 1024; ldt = 1024; }
            else if ((r -= I_IN) < I_V) { const int kb = r / 16, nb = r % 16; j0 = nb * 32; k0 = kb * 64; W = a.in[9] + (size_t)l * DM * 2560; ldw = 2560; s0 = 1024 + j0;
                WT = Wv + (size_t)l * 512 * 1024; ldt = 1024; }
            else { r -= I_V; const int kb = r / 32, nb = r % 32; j0 = nb * 32; k0 = kb * 64; W = a.in[15] + (size_t)l * DM * DM; ldw = DM; s0 = j0;
                WT = Wout + (size_t)l * 1024 * 1024; ldt = 1024; }
            transpose_item(W, ldw, s0, k0, WT, ldt, j0, scr, lane);
        }
    }
    for (int it = gw; it < NL * 4 * 128; it += NGW) {
        const int l = it >> 9, g = (it >> 7) & 3, k0 = (it & 127) * 8, d = lane;
        const float* wi = a.in[9] + ((size_t)l * DM + k0) * 2560 + 2304 + g * 64;
        const float* pw = a.in[13] + ((size_t)(l * 4 + g) * 64) * 64 + d;
        float acc[8];
#pragma unroll
        for (int i = 0; i < 8; ++i) acc[i] = 0.f;
#pragma unroll 4
        for (int c = 0; c < 64; ++c) { const float p = pw[c * 64];
#pragma unroll
            for (int i = 0; i < 8; ++i) acc[i] += wi[(size_t)i * 2560 + c] * p; }
        const float ps = a.in[14][l * 256 + g * 64 + d];
        u32x4 o; o.x = cvtpk(acc[0] * ps, acc[1] * ps); o.y = cvtpk(acc[2] * ps, acc[3] * ps); o.z = cvtpk(acc[4] * ps, acc[5] * ps); o.w = cvtpk(acc[6] * ps, acc[7] * ps);
        *(u32x4*)(Win + ((size_t)l * 2048 + 1792 + g * 64 + d) * 1024 + k0) = o;
    }
}

__device__ __forceinline__ void sw_rows(const bf16_t* Bt, int nrows, const float* shift, float* sW, int gw, int NGW, int lane) {
    float sh[8][16];
#pragma unroll
    for (int b = 0; b < 8; ++b)
#pragma unroll
        for (int j = 0; j < 2; ++j) { const f32x4 a0 = *(const f32x4*)(shift + (size_t)b * NMOD + j * 512 + 8 * lane), a1 = *(const f32x4*)(shift + (size_t)b * NMOD + j * 512 + 8 * lane + 4);
            sh[b][8 * j + 0] = a0[0]; sh[b][8 * j + 1] = a0[1]; sh[b][8 * j + 2] = a0[2]; sh[b][8 * j + 3] = a0[3]; sh[b][8 * j + 4] = a1[0]; sh[b][8 * j + 5] = a1[1]; sh[b][8 * j + 6] = a1[2]; sh[b][8 * j + 7] = a1[3]; }
    for (int row = gw; row < nrows; row += NGW) {
        const bf16_t* r = Bt + (size_t)row * 1024 + 8 * lane;
        const u32x4 w0 = *(const u32x4*)r, w1 = *(const u32x4*)(r + 512);
        float w[16];
        w[0] = bf_lo(w0.x); w[1] = bf_hi(w0.x); w[2] = bf_lo(w0.y); w[3] = bf_hi(w0.y); w[4] = bf_lo(w0.z); w[5] = bf_hi(w0.z); w[6] = bf_lo(w0.w); w[7] = bf_hi(w0.w);
        w[8] = bf_lo(w1.x); w[9] = bf_hi(w1.x); w[10] = bf_lo(w1.y); w[11] = bf_hi(w1.y); w[12] = bf_lo(w1.z); w[13] = bf_hi(w1.z); w[14] = bf_lo(w1.w); w[15] = bf_hi(w1.w);
        float v = 0.f;
#pragma unroll
        for (int b = 0; b < 8; ++b) { float acc = 0.f;
#pragma unroll
            for (int i = 0; i < 16; ++i) acc += sh[b][i] * w[i];
            acc = wave_sum(acc); v = (lane == b) ? acc : v; }
        if (lane < 8) sW[(size_t)lane * SW_ROWS + row] = v;
    }
}
__device__ __forceinline__ void init_xt(const float* xs, bf16_t* XT, bf16_t* XB, float* stats, const float* gain, const float* scale, int gw, int NGW, int lane) {
    for (int rb = gw; rb < MTOK / 16; rb += NGW) {
        const int row0 = rb * 16, b = row0 >> 12;
        f32x4 gs[4];
#pragma unroll
        for (int j = 0; j < 4; ++j) { const int col = 4 * lane + 256 * j; gs[j] = *(const f32x4*)(gain + col) * (*(const f32x4*)(scale + (size_t)b * NMOD + col) + 1.0f); }
#pragma unroll 2
        for (int i = 0; i < 16; ++i) {
            const float* xr = xs + (size_t)(row0 + i) * DM + 4 * lane;
            f32x4 v[4]; float ss = 0.f;
#pragma unroll
            for (int j = 0; j < 4; ++j) { v[j] = __builtin_nontemporal_load((const f32x4*)(xr + 256 * j)); ss += (v[j][0] * v[j][0] + v[j][1] * v[j][1]) + (v[j][2] * v[j][2] + v[j][3] * v[j][3]); }
            ss = wave_sum(ss);
            if (lane == 0) *(f32x4*)(stats + (size_t)(row0 + i) * 4) = (f32x4){ss, 0.f, 0.f, 0.f};
            bf16_t* hr = XT + (size_t)(row0 + i) * DM + 4 * lane;
#pragma unroll
            for (int j = 0; j < 4; ++j) { const f32x4 o = v[j] * gs[j]; u32x2 w; w.x = cvtpk(o[0], o[1]); w.y = cvtpk(o[2], o[3]); *(u32x2*)(hr + 256 * j) = w; }
            bf16_t* br = XB + (size_t)(row0 + i) * DM + 4 * lane;
#pragma unroll
            for (int j = 0; j < 4; ++j) { u32x2 w; w.x = cvtpk_h(v[j][0], v[j][1]); w.y = cvtpk_h(v[j][2], v[j][3]); *(u32x2*)(br + 256 * j) = w; }
        }
    }
}

constexpr int SB_PITCH = 144, SB_TILE = 64 * SB_PITCH, SB_WAVE_LDS = 2 * SB_TILE;
__device__ __forceinline__ void sb_ldg8(u32x4 (&r)[8], const bf16_t* g, size_t rowstride8) {
#pragma unroll
    for (int j = 0; j < 8; ++j) r[j] = *(const u32x4*)(g + j * rowstride8);
}
__device__ __forceinline__ void sb_attn_wave(const bf16_t* __restrict__ P, const bf16_t* __restrict__ Vt, bf16_t* __restrict__ mixed, int gw, int NGW, int lane, LAS unsigned char* wl) {
    constexpr int NUNITS = NBATCH * 8 * 128;
    const int r32 = lane & 31, hi = lane >> 5;
    const int pi = (r32 & 19) | ((r32 & 4) << 1) | ((r32 & 8) >> 1);
    const int lr = lane >> 3, lp = lane & 7;
    LAS unsigned char* kl = wl; LAS unsigned char* vl = wl + SB_TILE;
    const int wofs = lr * SB_PITCH + lp * 16;
    const int kro = pi * SB_PITCH + hi * 16;
    const int vro = r32 * SB_PITCH + hi * 16;
    int u = gw; if (u >= NUNITS) return;
    size_t tok0; int q0, h, kt; const bf16_t* kg; const bf16_t* vg;
    bf16x8 qf[4]; u32x4 ks[8], vs[8];
#define SB_UNIT_SETUP(uu) do { const int qg_ = (uu) & 127, bh_ = (uu) >> 7; h = bh_ & 7; tok0 = (size_t)(bh_ >> 3) * SEQ; q0 = qg_ * 32; kt = q0 >> 6; \
        const bf16_t* qp_ = P + (tok0 + q0 + r32) * PW + h * 64 + hi * 8; \
        kg = P + (tok0 + lr) * PW + 512 + h * 64 + lp * 8; vg = Vt + (size_t)(h * 64 + lr) * MTOK + tok0 + lp * 8; \
        _Pragma("unroll") for (int d0 = 0; d0 < 4; ++d0) qf[d0] = *(const bf16x8*)(qp_ + d0 * 16); \
        sb_ldg8(ks, kg + (size_t)kt * 64 * PW, (size_t)8 * PW); sb_ldg8(vs, vg + kt * 64, (size_t)8 * MTOK); } while (0)
    SB_UNIT_SETUP(u);
    for (;;) {
        f32x16 o0, o1;
#pragma unroll
        for (int r = 0; r < 16; ++r) { o0[r] = 0.f; o1[r] = 0.f; }
        float carry = 1.0f;
        const int tq = q0 + r32;
        bf16_t* op = mixed + (tok0 + q0 + r32) * DM + h * 64 + 4 * hi;
        for (;;) {
            const int k0 = kt * 64;
#pragma unroll
            for (int j = 0; j < 8; ++j) { *(LAS u32x4*)(kl + wofs + j * 8 * SB_PITCH) = ks[j]; *(LAS u32x4*)(vl + wofs + j * 8 * SB_PITCH) = vs[j]; }
            if (kt > 0) { sb_ldg8(ks, kg + (size_t)(kt - 1) * 64 * PW, (size_t)8 * PW); sb_ldg8(vs, vg + (k0 - 64), (size_t)8 * MTOK); }
            const bool diag = (k0 + 63 >= q0);
            const bool p1_dead = diag && ((q0 & 63) == 0);
            f32x16 p0, p1;
#pragma unroll
            for (int r = 0; r < 16; ++r) { p0[r] = 0.f; p1[r] = 0.f; }
#pragma unroll
            for (int d0 = 0; d0 < 4; ++d0) { const bf16x8 kf0 = *(const LAS bf16x8*)(kl + kro + d0 * 32); p0 = __builtin_amdgcn_mfma_f32_32x32x16_bf16(kf0, qf[d0], p0, 0, 0, 0); }
            if (!p1_dead) {
#pragma unroll
                for (int d0 = 0; d0 < 4; ++d0) { const bf16x8 kf1 = *(const LAS bf16x8*)(kl + kro + 32 * SB_PITCH + d0 * 32); p1 = __builtin_amdgcn_mfma_f32_32x32x16_bf16(kf1, qf[d0], p1, 0, 0, 0); }
            }
#define SB_HALF(PP, CH, CL, CIN, COUT) do { float rrh[2][8], Gh[2], Gph[2]; \
                _Pragma("unroll") for (int j = 1; j >= 0; --j) { float gp = 1.0f; \
                    _Pragma("unroll") for (int e = 0; e < 8; ++e) { const int idx = j * 8 + e; const float t = PP[idx]; \
                        const float ex = __builtin_amdgcn_exp2f(t); float r = __builtin_amdgcn_rcpf(1.0f + ex); float be = 1.0f - r; \
                        if (diag) { const int key = k0 + 16 * (j ? (CH) : (CL)) + 8 * hi + e; if (key >= tq) { r = 1.0f; be = 0.f; } } \
                        rrh[j][e] = r; PP[idx] = be; gp *= r; } \
                    Gh[j] = gp; } \
                Gph[1] = __shfl_xor(Gh[1], 32); Gph[0] = __shfl_xor(Gh[0], 32); \
                const float cn_ = (CIN), co_ = cn_ * (Gh[1] * Gph[1]); COUT = co_ * (Gh[0] * Gph[0]); \
                _Pragma("unroll") for (int j = 1; j >= 0; --j) { float run = (j ? cn_ : co_) * (hi == 0 ? Gph[j] : 1.0f); float av[8]; \
                    _Pragma("unroll") for (int e = 7; e >= 0; --e) { av[e] = PP[j * 8 + e] * run; run *= rrh[j][e]; } \
                    u32x4 w; w.x = cvtpk(av[0], av[1]); w.y = cvtpk(av[2], av[3]); w.z = cvtpk(av[4], av[5]); w.w = cvtpk(av[6], av[7]); \
                    const bf16x8 pbj = __builtin_bit_cast(bf16x8, w); const int c_ = j ? (CH) : (CL); \
                    const bf16x8 vf0 = *(const LAS bf16x8*)(vl + vro + c_ * 32), vf1 = *(const LAS bf16x8*)(vl + vro + 32 * SB_PITCH + c_ * 32); \
                    o0 = __builtin_amdgcn_mfma_f32_32x32x16_bf16(vf0, pbj, o0, 0, 0, 0); o1 = __builtin_amdgcn_mfma_f32_32x32x16_bf16(vf1, pbj, o1, 0, 0, 0); } } while (0)
            float cmid = carry;
            if (!p1_dead) SB_HALF(p1, 3, 2, carry, cmid);
            const bool done_mid = __all(cmid < 5.421010862427522e-20f);
            if (!done_mid) SB_HALF(p0, 1, 0, cmid, carry); else carry = cmid;
#undef SB_HALF
            if (kt == 0 || done_mid || __all(carry < 5.421010862427522e-20f)) break;
            --kt;
        }
        const int un = u + NGW; const bool hn = un < NUNITS;
        if (hn) { u = un; SB_UNIT_SETUP(u); }
#pragma unroll
        for (int a = 0; a < 4; ++a) {
            u32x2 w0; w0.x = cvtpk(o0[4 * a], o0[4 * a + 1]); w0.y = cvtpk(o0[4 * a + 2], o0[4 * a + 3]); *(u32x2*)(op + 8 * a) = w0;
            u32x2 w1; w1.x = cvtpk(o1[4 * a], o1[4 * a + 1]); w1.y = cvtpk(o1[4 * a + 2], o1[4 * a + 3]); *(u32x2*)(op + 32 + 8 * a) = w1;
        }
        if (!hn) break;
    }
#undef SB_UNIT_SETUP
}

__device__ __forceinline__ void ld8(const bf16_t* p, float (&v)[8]) {
    const u32x4 w = *(const u32x4*)p;
    v[0] = bf_lo(w.x); v[1] = bf_hi(w.x); v[2] = bf_lo(w.y); v[3] = bf_hi(w.y); v[4] = bf_lo(w.z); v[5] = bf_hi(w.z); v[6] = bf_lo(w.w); v[7] = bf_hi(w.w);
}
__device__ __forceinline__ void st8(bf16_t* p, const float (&v)[8]) {
    u32x4 w; w.x = cvtpk(v[0], v[1]); w.y = cvtpk(v[2], v[3]); w.z = cvtpk(v[4], v[5]); w.w = cvtpk(v[6], v[7]); *(u32x4*)p = w;
}
__device__ __forceinline__ void up8(const u32x4 w, float (&v)[8]) {
    v[0] = bf_lo(w.x); v[1] = bf_hi(w.x); v[2] = bf_lo(w.y); v[3] = bf_hi(w.y); v[4] = bf_lo(w.z); v[5] = bf_hi(w.z); v[6] = bf_lo(w.w); v[7] = bf_hi(w.w);
}
__device__ __forceinline__ void convpool_unit(const bf16_t* __restrict__ P, bf16_t* __restrict__ mixed, const float* convw, int uu, int lane) {
    const int c8 = (lane & 31) * 8, t0 = uu * 16 + (lane >> 5) * 8, s0 = t0 & (SEQ - 1);
    {
        float w0[8], w1[8], w2[8], p2[8], p1[8];
        const bf16_t* pc = P + 1280 + c8; const bf16_t* pu = P + 1536 + c8; const bf16_t* pb = P + 1024 + c8;
        {
            const bool hv = (s0 >= 2);
            const size_t tm2 = hv ? (size_t)(t0 - 2) : (size_t)t0, tm1 = hv ? (size_t)(t0 - 1) : (size_t)t0;
            const u32x4 a2 = *(const u32x4*)(pc + tm2 * PW), b2 = *(const u32x4*)(pu + tm2 * PW), a1 = *(const u32x4*)(pc + tm1 * PW), b1 = *(const u32x4*)(pu + tm1 * PW);
            float x[8], y[8];
            up8(a2, x); up8(b2, y);
#pragma unroll
            for (int i = 0; i < 8; ++i) p2[i] = hv ? x[i] * y[i] : 0.f;
            up8(a1, x); up8(b1, y);
#pragma unroll
            for (int i = 0; i < 8; ++i) p1[i] = hv ? x[i] * y[i] : 0.f;
#pragma unroll
            for (int i = 0; i < 8; ++i) { w0[i] = convw[c8 + i]; w1[i] = convw[256 + c8 + i]; w2[i] = convw[512 + c8 + i]; }
        }
#pragma unroll
        for (int ib = 0; ib < 8; ib += 4) {
            u32x4 rb[4], rc[4], ru[4];
#pragma unroll
            for (int k = 0; k < 4; ++k) { const size_t t = (size_t)(t0 + ib + k) * PW; rb[k] = *(const u32x4*)(pb + t); rc[k] = *(const u32x4*)(pc + t); ru[k] = *(const u32x4*)(pu + t); }
#pragma unroll
            for (int k = 0; k < 4; ++k) { float cb[8], cc[8], cu[8], y[8]; up8(rb[k], cb); up8(rc[k], cc); up8(ru[k], cu);
#pragma unroll
                for (int j = 0; j < 8; ++j) { const float cur = cc[j] * cu[j]; y[j] = cb[j] * (w0[j] * p2[j] + w1[j] * p1[j] + w2[j] * cur); p2[j] = p1[j]; p1[j] = cur; }
                st8(mixed + (size_t)(t0 + ib + k) * DM + 512 + c8, y); }
        }
    }
    {
        const int w = 2 << (c8 >> 6);
        const bf16_t* pp = P + 1792 + c8;
        float sum[8];
#pragma unroll
        for (int i = 0; i < 8; ++i) sum[i] = 0.f;
        {
            u32x4 r[16];
#pragma unroll
            for (int j = 1; j <= 16; ++j) { const bool ok = (j <= w) && (s0 - j >= 0); r[j - 1] = ok ? *(const u32x4*)(pp + (size_t)(t0 - (ok ? j : 0)) * PW) : (u32x4){0u, 0u, 0u, 0u}; }
#pragma unroll
            for (int j = 0; j < 16; ++j) { float v[8]; up8(r[j], v);
#pragma unroll
                for (int i = 0; i < 8; ++i) sum[i] += v[i]; }
        }
#pragma unroll
        for (int ib = 0; ib < 8; ib += 4) {
            u32x4 rc[4], ro[4];
#pragma unroll
            for (int k = 0; k < 4; ++k) { const int s = s0 + ib + k; const bool ok = (s - w >= 0);
                rc[k] = *(const u32x4*)(pp + (size_t)(t0 + ib + k) * PW);
                ro[k] = ok ? *(const u32x4*)(pp + (size_t)(t0 + ib + k - (ok ? w : 0)) * PW) : (u32x4){0u, 0u, 0u, 0u}; }
#pragma unroll
            for (int k = 0; k < 4; ++k) { const int s = s0 + ib + k; float cur[8], old[8], y[8]; up8(rc[k], cur); up8(ro[k], old);
                const float inv = 1.0f / (float)((s + 1 < w) ? (s + 1) : w);
#pragma unroll
                for (int j = 0; j < 8; ++j) { sum[j] += cur[j] - old[j]; y[j] = sum[j] * inv - cur[j]; }
                st8(mixed + (size_t)(t0 + ib + k) * DM + 768 + c8, y); }
        }
    }
}

constexpr int LDS_BYTES = 8 * SB_WAVE_LDS + 256;
constexpr int N_STEPS = 2 + NL * 7;

__global__ void __launch_bounds__(512, 2) fwd_kernel(Args a) {
    extern __shared__ __attribute__((aligned(16))) unsigned char lds_raw[];
    cg::grid_group grid = cg::this_grid();
    LAS unsigned char* lds = (LAS unsigned char*)lds_raw;
    const int G = gridDim.x, NGW = G * 8;
    const int wave0 = __builtin_amdgcn_readfirstlane((int)threadIdx.x >> 6);
#define LANE_VARS int tid = wave0 * 64 + (int)__builtin_amdgcn_mbcnt_hi(~0u, __builtin_amdgcn_mbcnt_lo(~0u, 0u)); asm volatile("" : "+v"(tid)); const int lane = tid & 63, wave = wave0, gw = blockIdx.x * 8 + wave; (void)lane; (void)gw
    unsigned char* ws = a.ws;
    const float* mod = (const float*)(ws + WS_MOD);
    const bf16_t* Wgu = (const bf16_t*)(ws + WS_WGU); const bf16_t* Wd = (const bf16_t*)(ws + WS_WD); const bf16_t* Win = (const bf16_t*)(ws + WS_WIN);
    const bf16_t* Wv = (const bf16_t*)(ws + WS_WV); const bf16_t* Wout = (const bf16_t*)(ws + WS_WOUT);
    float* STATS = (float*)(ws + WS_STATS); float* SWB = (float*)(ws + WS_SW); bf16_t* MIX = (bf16_t*)(ws + WS_MIX); bf16_t* XB = (bf16_t*)(ws + WS_XB); LAS float* scr = (LAS float*)(lds + pg8::STAGE_BYTES);
    bf16_t* H = (bf16_t*)(ws + WS_H); bf16_t* ACT = (bf16_t*)(ws + WS_ACT); bf16_t* PROJ = (bf16_t*)(ws + WS_PROJ); bf16_t* VT = (bf16_t*)(ws + WS_VT);
    const int lo = a.lo, hi = a.hi;
    int step = 0;
#define STEP_ON (step >= lo && step < hi)
    volatile LAS unsigned* bst = (volatile LAS unsigned*)(lds + 8 * SB_WAVE_LDS);
    if (threadIdx.x == 0) { bst[0] = 0u; bst[1] = 0u; }
    unsigned* barw = (unsigned*)(ws + WS_CTL);
    if (blockIdx.x == 0 && lo == 0) for (int i = threadIdx.x; i < XCD_BAR_WORDS; i += 512) __hip_atomic_store(barw + i, 0u, __ATOMIC_RELAXED, __HIP_MEMORY_SCOPE_AGENT);
    __syncthreads();
    XcdBarrier xb; xb.bar = barw; xb.x = 0; xb.st = bst;
#define STEP_END do { ++step; if (step > lo && step < hi) { if (step == 1) { grid.sync(); xb = xcd_barrier_post(barw, bst, wave0); } else xcd_barrier(xb, wave0); } } while (0)

    if (STEP_ON) { LANE_VARS; for (int rep = 0; rep < REP_PRO; ++rep) { prologue(a, lds, tid, lane, wave, gw, NGW); __syncthreads(); } }
    STEP_END;
    if (STEP_ON) { LANE_VARS;
        for (int l = 0; l < NL; ++l) {
            const float* modl = mod + (size_t)l * 8 * NMOD; float* sWl = SWB + (size_t)l * 8 * SW_ROWS;
            sw_rows(Wgu + (size_t)(l * 2) * 5632 * 1024, 5632, modl, sWl + SW_GU1, gw, NGW, lane);
            sw_rows(Win + (size_t)l * 2048 * 1024, 2048, modl + 3072, sWl + SW_IN, gw, NGW, lane);
            sw_rows(Wv + (size_t)l * 512 * 1024, 512, modl + 3072, sWl + SW_V, gw, NGW, lane);
            sw_rows(Wgu + (size_t)(l * 2 + 1) * 5632 * 1024, 5632, modl + 6144, sWl + SW_GU2, gw, NGW, lane);
        }
        init_xt(a.in[0], H, XB, STATS, a.in[4], mod + 1024, gw, NGW, lane);
    }
    STEP_END;

    for (int l = 0; l < NL; ++l) {
        const float* modl = mod + (size_t)l * 8 * NMOD; const float* sWl = SWB + (size_t)l * 8 * SW_ROWS;
        for (int s = 0; s < 3; ++s) {
            if (s != 1) {
                const int f = (s == 0) ? 0 : 1;
                if (STEP_ON) { LANE_VARS;
#define GU_BLOCK { pg8::Gemm g{H, Wgu + (size_t)(l * 2 + f) * 5632 * 1024, MTOK, 5632, DM}; pg8::StaticOrderC<MTOK / 256, 22> S; S.init(MTOK, 5632, G, (int)blockIdx.x); \
                    pg8::EpiSwiGLU E{ACT, STATS, sWl + (f ? SW_GU2 : SW_GU1), scr}; pg8::gemm_phase(lds, g, S, E, tid); }
                    for (int rep = 0; rep < REP_GU; ++rep) GU_BLOCK
                }
                STEP_END;
            } else {
                if (STEP_ON) { LANE_VARS; {
                    { pg8::Gemm g{H, Win + (size_t)l * 2048 * 1024, MTOK, 2048, DM}; pg8::StaticOrderC<MTOK / 256, 8> S; S.init(MTOK, 2048, G, (int)blockIdx.x);
                      pg8::EpiIn E{PROJ, a.in[10] + l * 64, a.in[11] + l * 64, STATS, sWl + SW_IN, scr};
                      pg8::gemm_phase(lds, g, S, E, tid); }
                    { pg8::Gemm g{Wv + (size_t)l * 512 * 1024, H, 512, MTOK, DM}; pg8::StaticOrderC<2, MTOK / 256> S; S.init(512, MTOK, G, (int)blockIdx.x);
                      pg8::EpiVt E{VT, STATS, sWl + SW_V, scr};
                      pg8::gemm_phase(lds, g, S, E, tid); }
                } }
                STEP_END;
                if (STEP_ON) { LANE_VARS; for (int rep = 0; rep < REP_MIX; ++rep) {
                    sb_attn_wave(PROJ, VT, MIX, gw, NGW, lane, lds + wave * SB_WAVE_LDS);
                    for (int u = gw; u < MTOK / 16; u += NGW) convpool_unit(PROJ, MIX, a.in[12] + (size_t)l * 768, u, lane);
                } }
                STEP_END;
            }
            if (STEP_ON) { LANE_VARS;
                const bf16_t* gA = (s != 1) ? (const bf16_t*)ACT : (const bf16_t*)MIX;
                const bf16_t* gB = (s != 1) ? Wd + (size_t)(l * 2 + (s == 0 ? 0 : 1)) * 1024 * FF : Wout + (size_t)l * 1024 * 1024;
                const int gK = (s != 1) ? FF : DM;
                const pg8::Gemm g{gA, gB, MTOK, DM, gK};
                pg8::StaticOrderC<MTOK / 256, 4> S; S.init(MTOK, DM, G, (int)blockIdx.x);
                const bool has_next = !(l == NL - 1 && s == 2);
                const int ln = (s == 2) ? l + 1 : l, sn = (s == 2) ? 0 : s + 1;
                const float* gain_n = (sn == 0 ? a.in[4] : sn == 1 ? a.in[8] : a.in[16]) + (size_t)(has_next ? ln : 0) * DM;
                const float* scale_n = mod + (size_t)(has_next ? ln : 0) * 8 * NMOD + sn * 3072 + 1024;
                bf16_t* xt = has_next ? H : (bf16_t*)nullptr;
                const float* gatep = modl + s * 3072 + 2048;
                const float coef = (s == 1) ? 1.0f : 0.5f;
                const pg8::EpiRes E{XB, XB, a.out, gatep, xt, gain_n, scale_n, STATS, scr, coef};
                pg8::gemm_phase(lds, g, S, E, tid);
            }
            STEP_END;
        }
    }
#undef STEP_ON
#undef STEP_END
}

extern "C" void kernel_launch(void* const* d_in, const int* in_sizes, int n_in, void* d_out, int out_size, void* d_ws, size_t ws_size, hipStream_t stream) {
    static int grid = 0;
    if (grid == 0) {
        if (n_in != 20 || out_size != MTOK * DM || ws_size < WS_END) { fprintf(stderr, "kernel_launch: unexpected problem (n_in %d, out %d, ws %zu)\n", n_in, out_size, ws_size); grid = -1; return; }
        int dev = 0, cus = 0, per_cu = 0;
        (void)hipGetDevice(&dev); (void)hipDeviceGetAttribute(&cus, hipDeviceAttributeMultiprocessorCount, dev);
        if (hipFuncSetAttribute((const void*)fwd_kernel, hipFuncAttributeMaxDynamicSharedMemorySize, LDS_BYTES) != hipSuccess) fprintf(stderr, "kernel_launch: hipFuncSetAttribute failed\n");
        if (hipOccupancyMaxActiveBlocksPerMultiprocessor(&per_cu, (const void*)fwd_kernel, 512, LDS_BYTES) != hipSuccess || per_cu < 1) { fprintf(stderr, "kernel_launch: occupancy query gave %d\n", per_cu); per_cu = 1; }
        (void)hipGetLastError();
        grid = cus * per_cu;
        fprintf(stderr, "kernel_launch: grid %d (cus %d x %d)\n", grid, cus, per_cu);
    }
    if (grid < 0) return;
    Args a{};
    for (int i = 0; i < 20; ++i) a.in[i] = (const float*)d_in[i];
    a.out = (float*)d_out; a.ws = (unsigned char*)d_ws;
#if MK_MULTI_LAUNCH
    for (int st = 0; st < N_STEPS; ++st) { a.lo = st; a.hi = st + 1; hipLaunchKernelGGL(fwd_kernel, dim3(grid), dim3(512), LDS_BYTES, stream, a); }
#else
    a.lo = 0; a.hi = N_STEPS;
    void* args[] = {&a};
    hipError_t e = hipLaunchCooperativeKernel((const void*)fwd_kernel, dim3(grid), dim3(512), args, LDS_BYTES, stream);
    if (e != hipSuccess) fprintf(stderr, "kernel_launch: cooperative launch failed: %s (grid %d)\n", hipGetErrorString(e), grid);
#endif
}
```
